# Optimizing an MI355X kernel written in HIP

```python
import math
import jax
import jax.numpy as jnp
from jax import lax
import numpy as np

D_MODEL = 2048
BATCH = 4
SEQ = 2048
DEPTH = 2

D_FF = 5632
RG_HEADS = 8
RG_DK = 128
RG_DV = 128
RG_WIDTH = RG_HEADS * RG_DV
CHUNK = 64
ATT_HEADS = 8
ATT_KV_HEADS = 2
ATT_GROUP = ATT_HEADS // ATT_KV_HEADS
ATT_HD = 128
ATT_WIDTH = ATT_HEADS * ATT_HD
KV_WIDTH = ATT_KV_HEADS * ATT_HD
WINDOW = 128
Q_BLOCK = 128
IN_SIZES = (RG_WIDTH, RG_WIDTH, RG_WIDTH, RG_WIDTH, RG_WIDTH, ATT_WIDTH, KV_WIDTH, KV_WIDTH, D_MODEL, D_MODEL)
IN_COLS = 5 * RG_WIDTH + ATT_WIDTH + 2 * KV_WIDTH + 2 * D_MODEL
EPS = 1e-6

kernel_name = "hybrid_hgrn2_window_gqa_macaron_encoder"


def rmsnorm(x, gain):
    xf = x.astype(jnp.float32)
    y = xf * lax.rsqrt(jnp.mean(xf * xf, axis=-1, keepdims=True) + EPS)
    return (y * gain.astype(jnp.float32)).astype(x.dtype)


def swiglu(h, w_gate, w_up, w_down):
    return (jax.nn.silu(h @ w_gate) * (h @ w_up)) @ w_down


def lower_bounds(lb_logits):
    lb = jnp.cumsum(jax.nn.softmax(lb_logits.astype(jnp.float32), axis=0), axis=0)
    return lb - lb[0:1]


def hgrn2_direction(q, k, v, log_f):
    B, S, H, DK = q.shape
    DV = v.shape[-1]
    n = S // CHUNK

    def to_chunks(t):
        return t.reshape(B, n, CHUNK, H, t.shape[-1]).transpose(1, 0, 3, 2, 4)

    qc, kc, vc, ac = to_chunks(q), to_chunks(k), to_chunks(v), to_chunks(log_f)
    causal_in_chunk = jnp.tril(jnp.ones((CHUNK, CHUNK), dtype=bool))[:, :, None]

    def step(state, inp):
        qi, ki, vi, ai = inp
        b = jnp.cumsum(ai, axis=2)
        rel = b[:, :, :, None, :] - b[:, :, None, :, :]
        decay = jnp.exp(jnp.where(causal_in_chunk, rel, -jnp.inf))
        scores = jnp.einsum('bhtd,bhsd,bhtsd->bhts', qi, ki, decay)
        o_intra = jnp.einsum('bhts,bhsv->bhtv', scores, vi)
        o_inter = jnp.einsum('bhtd,bhdv->bhtv', qi * jnp.exp(b), state)
        b_last = b[:, :, -1:, :]
        k_dec = ki * jnp.exp(b_last - b)
        new_state = jnp.exp(b_last[:, :, 0, :])[..., None] * state + jnp.einsum('bhsd,bhsv->bhdv', k_dec, vi)
        return new_state, o_intra + o_inter

    state0 = jnp.zeros((B, H, DK, DV), jnp.float32)
    _, o = lax.scan(step, state0, (qc, kc, vc, ac))
    return o.transpose(1, 0, 3, 2, 4).reshape(B, S, H, DV)


def hgrn2_mixer(q, i, zf, zb, g, lb_f, lb_b, out_gain):
    B, S, _ = q.shape
    dt = q.dtype

    def heads(t):
        return t.astype(jnp.float32).reshape(B, S, RG_HEADS, -1)

    qh, vh = heads(q), heads(i)

    def gates(z, lb):
        z = heads(z)
        lb = lb.astype(jnp.float32).reshape(RG_HEADS, RG_DK)
        log_f = jnp.logaddexp(jnp.log(lb), jnp.log1p(-lb) + jax.nn.log_sigmoid(z))
        key = (1.0 - lb) * jax.nn.sigmoid(-z)
        return key, log_f

    k_f, a_f = gates(zf, lb_f)
    k_b, a_b = gates(zb, lb_b)
    o_fwd = hgrn2_direction(qh, k_f, vh, a_f)
    flip = lambda t: jnp.flip(t, axis=1)
    o_bwd = flip(hgrn2_direction(flip(qh), flip(k_b), flip(vh), flip(a_b)))
    o = o_fwd + o_bwd
    o = o * lax.rsqrt(jnp.mean(o * o, axis=-1, keepdims=True) + EPS)
    o = o * out_gain.astype(jnp.float32).reshape(RG_HEADS, RG_DV)
    o = o.reshape(B, S, RG_WIDTH) * jax.nn.silu(g.astype(jnp.float32))
    return o.astype(dt)


def window_gqa(q, k, v, sink):
    B, S, _ = q.shape
    dt = q.dtype
    nb = S // Q_BLOCK
    qb = q.reshape(B, nb, Q_BLOCK, ATT_KV_HEADS, ATT_GROUP, ATT_HD)

    def band(t):
        tp = jnp.pad(t.reshape(B, S, ATT_KV_HEADS, ATT_HD), ((0, 0), (Q_BLOCK, Q_BLOCK), (0, 0), (0, 0)))
        tb = tp.reshape(B, nb + 2, Q_BLOCK, ATT_KV_HEADS, ATT_HD)
        return jnp.concatenate([tb[:, :-2], tb[:, 1:-1], tb[:, 2:]], axis=2)

    kb, vb = band(k), band(v)
    qi = jnp.arange(Q_BLOCK)[:, None]
    kj = jnp.arange(3 * Q_BLOCK)[None, :]
    rel = kj - Q_BLOCK - qi
    kpos = jnp.arange(nb)[:, None, None] * Q_BLOCK + kj[None] - Q_BLOCK
    valid = (jnp.abs(rel) <= WINDOW)[None] & (kpos >= 0) & (kpos < S)

    slopes = 2.0 ** (-8.0 * jnp.arange(1, ATT_HEADS + 1, dtype=jnp.float32) / ATT_HEADS)
    slopes = slopes.reshape(ATT_KV_HEADS, ATT_GROUP)
    dist = jnp.abs(rel).astype(jnp.float32)

    s = jnp.einsum('bnqhgd,bnkhd->bnhgqk', qb, kb).astype(jnp.float32) * (1.0 / math.sqrt(ATT_HD))
    s = s - slopes[:, :, None, None] * dist
    s = jnp.where(valid[None, :, None, None], s, -jnp.inf)
    sink_logit = jnp.broadcast_to(sink.astype(jnp.float32).reshape(ATT_KV_HEADS, ATT_GROUP)[:, :, None, None],
                                  (B, nb, ATT_KV_HEADS, ATT_GROUP, Q_BLOCK, 1))
    p = jax.nn.softmax(jnp.concatenate([s, sink_logit], axis=-1), axis=-1)[..., :-1]
    o = jnp.einsum('bnhgqk,bnkhd->bnqhgd', p.astype(dt), vb)
    return o.reshape(B, S, ATT_WIDTH)


def setup_inputs(seed: int = 0) -> dict:
    key = jax.random.key(seed)
    ks = jax.random.split(key, 20)

    def w(k, shape, fan_in):
        return jax.random.normal(k, shape, jnp.float32) * (fan_in ** -0.5)

    def gain(k, shape):
        return 1.0 + 0.02 * jax.random.normal(k, shape, jnp.float32)

    return {
        "x": jax.random.normal(ks[0], (BATCH, SEQ, D_MODEL), jnp.float32),
        "ffn1_norm": gain(ks[1], (DEPTH, D_MODEL)),
        "ffn1_w_gate": w(ks[2], (DEPTH, D_MODEL, D_FF), D_MODEL),
        "ffn1_w_up": w(ks[3], (DEPTH, D_MODEL, D_FF), D_MODEL),
        "ffn1_w_down": w(ks[4], (DEPTH, D_FF, D_MODEL), D_FF),
        "mix_norm": gain(ks[5], (DEPTH, D_MODEL)),
        "w_in": w(ks[6], (DEPTH, D_MODEL, IN_COLS), D_MODEL),
        "lb_fwd_logits": 0.5 * jax.random.normal(ks[7], (DEPTH, RG_WIDTH), jnp.float32),
        "lb_bwd_logits": 0.5 * jax.random.normal(ks[8], (DEPTH, RG_WIDTH), jnp.float32),
        "rg_out_norm": gain(ks[9], (DEPTH, RG_WIDTH)),
        "attn_sink": 0.5 * jax.random.normal(ks[10], (DEPTH, ATT_HEADS), jnp.float32),
        "w_branch_a": w(ks[11], (DEPTH, RG_WIDTH, D_MODEL), RG_WIDTH),
        "w_branch_b": w(ks[12], (DEPTH, ATT_WIDTH, D_MODEL), ATT_WIDTH),
        "w_out": w(ks[13], (DEPTH, D_MODEL, D_MODEL), D_MODEL),
        "ffn2_norm": gain(ks[14], (DEPTH, D_MODEL)),
        "ffn2_w_gate": w(ks[15], (DEPTH, D_MODEL, D_FF), D_MODEL),
        "ffn2_w_up": w(ks[16], (DEPTH, D_MODEL, D_FF), D_MODEL),
        "ffn2_w_down": w(ks[17], (DEPTH, D_FF, D_MODEL), D_FF),
        "final_norm": gain(ks[18], (D_MODEL,)),
    }


def reference(x, ffn1_norm, ffn1_w_gate, ffn1_w_up, ffn1_w_down, mix_norm, w_in, lb_fwd_logits,
              lb_bwd_logits, rg_out_norm, attn_sink, w_branch_a, w_branch_b, w_out, ffn2_norm,
              ffn2_w_gate, ffn2_w_up, ffn2_w_down, final_norm):
    split_at = [int(c) for c in np.cumsum(IN_SIZES)[:-1]]
    lb_f_all = lower_bounds(lb_fwd_logits)
    lb_b_all = lower_bounds(lb_bwd_logits)
    for l in range(DEPTH):
        h = rmsnorm(x, ffn1_norm[l])
        x = x + 0.5 * swiglu(h, ffn1_w_gate[l], ffn1_w_up[l], ffn1_w_down[l])
        h = rmsnorm(x, mix_norm[l])
        p = h @ w_in[l]
        rq, ri, rzf, rzb, rg, aq, ak, av, ga, gb = jnp.split(p, split_at, axis=-1)
        o_a = hgrn2_mixer(rq, ri, rzf, rzb, rg, lb_f_all[l], lb_b_all[l], rg_out_norm[l])
        o_b = window_gqa(aq, ak, av, attn_sink[l])
        merged = jax.nn.sigmoid(ga) * (o_a @ w_branch_a[l]) + jax.nn.sigmoid(gb) * (o_b @ w_branch_b[l])
        x = x + merged @ w_out[l]
        h = rmsnorm(x, ffn2_norm[l])
        x = x + 0.5 * swiglu(h, ffn2_w_gate[l], ffn2_w_up[l], ffn2_w_down[l])
    return rmsnorm(x, final_norm)
```

```cpp
#include <hip/hip_runtime.h>
#include <hip/hip_cooperative_groups.h>
#include <cstdio>
namespace cg = cooperative_groups;

#define LAS __attribute__((address_space(3)))
typedef unsigned short bf16_t;
typedef short bf16x8 __attribute__((ext_vector_type(8)));
typedef short bf16x4 __attribute__((ext_vector_type(4)));
typedef float f32x4 __attribute__((ext_vector_type(4)));
typedef float f32x2 __attribute__((ext_vector_type(2)));
typedef unsigned u32x4 __attribute__((ext_vector_type(4)));
typedef unsigned u32x2 __attribute__((ext_vector_type(2)));

constexpr int T = 8192, D = 2048, FF = 5632, INC = 10752, SEQ = 2048, RGW = 1024;
constexpr float EPS = 1e-6f;
constexpr int NTHREADS = 512, NWAVES = 8;
constexpr int LDS_BAR_OFF = 155648;
constexpr int LDS_BYTES = LDS_BAR_OFF + 16;

constexpr int PC_Q = 0, PC_I = 1024, PC_ZF = 2048, PC_ZB = 3072, PC_G = 4096, PC_AQ = 5120, PC_AK = 6144, PC_AV = 6400, PC_GA = 6656, PC_GB = 8704;

constexpr size_t SZ_WGU = (size_t)2 * FF * D * 2, SZ_WD = (size_t)D * FF * 2, SZ_WIN = (size_t)INC * D * 2, SZ_WAB = (size_t)D * RGW * 2, SZ_WOUT = (size_t)D * D * 2;
constexpr size_t OFF_WGU1 = 0, OFF_WD1 = OFF_WGU1 + SZ_WGU, OFF_WIN = OFF_WD1 + SZ_WD, OFF_WA = OFF_WIN + SZ_WIN, OFF_WB = OFF_WA + SZ_WAB, OFF_WOUT = OFF_WB + SZ_WAB,
                 OFF_WGU2 = OFF_WOUT + SZ_WOUT, OFF_WD2 = OFF_WGU2 + SZ_WGU, SZ_LAYER = OFF_WD2 + SZ_WD;
constexpr size_t WS_X = 2 * SZ_LAYER, WS_XB = WS_X + (size_t)T * D * 4, WS_SS = WS_XB + (size_t)T * D * 2, WS_BAR = WS_SS + (size_t)8 * T * 8, WS_REG = WS_BAR + 16384;
constexpr size_t WS_ACT = WS_REG;
constexpr size_t WS_P = WS_REG;
constexpr size_t WS_OF = WS_P + (size_t)T * INC * 2;
constexpr size_t WS_OB = WS_OF + (size_t)T * RGW * 4;
constexpr size_t WS_OA = WS_OB + (size_t)T * RGW * 4;
constexpr size_t WS_OT = WS_OA + (size_t)T * RGW * 2;
constexpr size_t WS_MG = WS_OT + (size_t)T * RGW * 2;
constexpr size_t WS_END = WS_MG + (size_t)T * D * 2;

struct Params {
    const float* x; const float* ffn1_norm; const float* ffn1_wg; const float* ffn1_wu; const float* ffn1_wd; const float* mix_norm; const float* w_in;
    const float* lbf; const float* lbb; const float* rg_norm; const float* sink; const float* wa; const float* wb; const float* wout;
    const float* ffn2_norm; const float* ffn2_wg; const float* ffn2_wu; const float* ffn2_wd; const float* final_norm;
    float* out; unsigned char* ws;
};

__device__ __forceinline__ unsigned pk2(float lo, float hi) { unsigned r; asm("v_cvt_pk_bf16_f32 %0, %1, %2" : "=v"(r) : "v"(lo), "v"(hi)); return r; }
__device__ __forceinline__ float bf_lo(unsigned w) { return __uint_as_float(w << 16); }
__device__ __forceinline__ float bf_hi(unsigned w) { return __uint_as_float(w & 0xffff0000u); }
__device__ __forceinline__ float bf1(bf16_t w) { return __uint_as_float(((unsigned)w) << 16); }
__device__ __forceinline__ float wave_sum(float v) {
#pragma unroll
    for (int o = 1; o < 64; o <<= 1) v += __shfl_xor(v, o);
    return v;
}
__device__ __forceinline__ float fexp(float v) { return __builtin_amdgcn_exp2f(v * 1.4426950408889634f); }
__device__ __forceinline__ float flog(float v) { return __builtin_amdgcn_logf(v) * 0.6931471805599453f; }
__device__ __forceinline__ float sigmoidf_(float v) { return __builtin_amdgcn_rcpf(1.0f + fexp(-v)); }
#define LDS_WAIT() asm volatile("s_waitcnt lgkmcnt(0)" ::: "memory")
#define LDS_BARRIER() do { asm volatile("s_waitcnt lgkmcnt(0)" ::: "memory"); __builtin_amdgcn_s_barrier(); asm volatile("" ::: "memory"); } while (0)
__device__ __forceinline__ int opaque_tid() { int t = threadIdx.x; asm volatile("" : "+v"(t)); return t; }


#define XB_TMO      128
#define XB_XCNT(j)  (256  + 64 * (j))
#define XB_XSUB(j)  (1280 + 64 * (j))
#define XB_XGEN(j)  (2304 + 64 * (j))
#define XB_TOP      3328
#define XB_TOPGEN   3392
#define XCD_BAR_WORDS 3456
#define XB_SPIN_CAP (1u << 22)
__device__ __forceinline__ unsigned xb_ld(unsigned* p)              { return __hip_atomic_load(p, __ATOMIC_RELAXED, __HIP_MEMORY_SCOPE_AGENT); }
__device__ __forceinline__ unsigned xb_add(unsigned* p, unsigned v) { return __hip_atomic_fetch_add(p, v, __ATOMIC_RELAXED, __HIP_MEMORY_SCOPE_AGENT); }
__device__ __forceinline__ unsigned xb_xcc_id() { return (unsigned)__builtin_amdgcn_s_getreg((3 << 11) | 20) & 0xFu; }
#define XB_SPIN(cond, bar) do { unsigned _sp = 0; while (cond) { __builtin_amdgcn_s_sleep(1); \
    if ((++_sp & 255u) == 0u) { if (xb_ld(&(bar)[XB_TMO])) break; if (_sp > XB_SPIN_CAP) { atomicAdd(&(bar)[XB_TMO], 1u); break; } } } } while (0)
struct XcdBarrier { unsigned* bar; unsigned x; volatile LAS unsigned* st; };
__device__ __forceinline__ XcdBarrier xcd_barrier_post(unsigned* bar, volatile LAS unsigned* st) {
    XcdBarrier b; b.bar = bar; b.x = xb_xcc_id(); b.st = st;
    if (threadIdx.x == 0) (void)xb_add(&bar[XB_XCNT(b.x)], 1u);
    return b;
}
__device__ __forceinline__ void xcd_barrier_complete(unsigned* bar, unsigned x, unsigned& nloc, unsigned& nx) {
    const unsigned G = gridDim.x * gridDim.y * gridDim.z;
    unsigned sum, cnt, mine, sp = 0u;
    for (;;) {
        sum = 0u; cnt = 0u; mine = 0u;
#pragma unroll
        for (unsigned j = 0; j < 16; ++j) { const unsigned c = xb_ld(&bar[XB_XCNT(j)]); sum += c; cnt += (c > 0u) ? 1u : 0u; mine = (j == x) ? c : mine; }
        if (sum == G) break;
        __builtin_amdgcn_s_sleep(1);
        if ((++sp & 255u) == 0u) { if (xb_ld(&bar[XB_TMO])) break; if (sp > XB_SPIN_CAP) { atomicAdd(&bar[XB_TMO], 1u); break; } }
    }
    nloc = mine > 0u ? mine : 1u; nx = cnt > 0u ? cnt : 1u;
}
__device__ __forceinline__ void xcd_barrier(const XcdBarrier& b) {
    asm volatile("s_waitcnt vmcnt(0)" ::: "memory");
    __syncthreads();
    if (threadIdx.x == 0) {
        unsigned* bar = b.bar; unsigned bx = b.x; asm volatile("" : "+s"(bx));
        __builtin_amdgcn_s_waitcnt(0);
        unsigned nloc = b.st[0], nx = b.st[1];
        if (nloc == 0u) { xcd_barrier_complete(bar, bx, nloc, nx); b.st[0] = nloc; b.st[1] = nx; }
        const unsigned old = xb_add(&bar[XB_XSUB(bx)], 1u);
        const unsigned gen = old / nloc;
        if (old + 1u == (gen + 1u) * nloc) {
            __builtin_amdgcn_fence(__ATOMIC_RELEASE, "agent");
            asm volatile("s_waitcnt vmcnt(0)" ::: "memory");
            const unsigned og = xb_add(&bar[XB_TOP], 1u);
            const unsigned tg = og / nx;
            if (og + 1u == (tg + 1u) * nx) xb_add(&bar[XB_TOPGEN], 1u);
            else XB_SPIN(xb_ld(&bar[XB_TOPGEN]) == tg, bar);
            __builtin_amdgcn_fence(__ATOMIC_ACQUIRE, "agent");
            xb_add(&bar[XB_XGEN(bx)], 1u);
            asm volatile("s_waitcnt vmcnt(0)" ::: "memory");
        } else {
            XB_SPIN(xb_ld(&bar[XB_XGEN(bx)]) == gen, bar);
            __builtin_amdgcn_fence(__ATOMIC_ACQUIRE, "agent");
            asm volatile("s_waitcnt vmcnt(0)" ::: "memory");
        }
    }
    __syncthreads();
}

namespace pg8 {
constexpr int BM = 256, BK = 64, HALF = 128, HTB = HALF * BK * 2, STAGE_BYTES = 8 * HTB, NXCD = 8, WGM = 8;
__host__ __device__ __forceinline__ int lds_byte(int r, int c) { const int st = (r >> 4) * 2 + (c >> 5), rr = r & 15, cc = c & 31, ob = rr * 64 + cc * 2; return st * 1024 + (ob ^ (((ob >> 9) & 1) << 5)); }
__host__ __device__ __forceinline__ void stage_rc(int b, int& R, int& C) { const int st = b / 1024, sb = b % 1024, swz = sb ^ (((sb >> 9) & 1) << 5); R = (st >> 1) * 16 + swz / 64; C = (st & 1) * 32 + (swz % 64) / 2; }
__host__ __device__ __forceinline__ int perm32(int rho) { const int n = rho >> 4, i = rho & 15; return 8 * (i >> 2) + 4 * n + (i & 3); }

struct Unit { int pm, pn, kind; };
struct Gemm { const bf16_t* A0; const bf16_t* B0; const bf16_t* A1; const bf16_t* B1; int M, N, K; };

struct StaticOrder {
    int nM, nN, nwg, G, c;
    __device__ void init(int M, int N, int G_, int c_) { nM = M / BM; nN = N / BM; nwg = nM * nN; G = G_; c = c_; }
    __device__ bool next(int i, Unit& u) const {
        const long L = (long)i * G + c; if (L >= nwg) return false;
        int wgid = (int)L; { const int q = nwg / NXCD, r = nwg % NXCD, xcd = wgid % NXCD, off = wgid / NXCD; wgid = (xcd < r ? xcd * (q + 1) : r * (q + 1) + (xcd - r) * q) + off; }
        const int nig = WGM * nN, gid = wgid / nig, fm = gid * WGM, gsz = (nM - fm) < WGM ? (nM - fm) : WGM;
        u.pm = fm + ((wgid % nig) % gsz); u.pn = (wgid % nig) / gsz; u.kind = 0; return true;
    }
};
struct PairOrder {
    StaticOrder so;
    __device__ void init(int M, int N, int G_, int c_) { so.init(M, N, G_, c_); }
    __device__ bool next(int i, Unit& u) const { if (!so.next(i >> 1, u)) return false; u.kind = i & 1; return true; }
};

template <class Epi, class Sched, bool ALIGN_EPI = true, bool SP2 = true>
__device__ __forceinline__ void gemm_phase(LAS unsigned char* lds, const Gemm g, const Sched& S, const Epi& E) {
    const int tid = opaque_tid(), wid = __builtin_amdgcn_readfirstlane(tid >> 6), lane = tid & 63, wr = wid >> 2, wc = wid & 3, fr = lane & 15, fq = lane >> 4;
    const int K = g.K, nt = K / BK;
    unsigned voffA[2], voffB[2];
#pragma unroll
    for (int i = 0; i < 2; ++i) { int R, C; stage_rc(tid * 16 + i * 8192, R, C); const int Rb = Epi::PERM ? ((R & ~31) + perm32(R & 31)) : R;
        voffA[i] = (unsigned)(R * K + C) * 2u; voffB[i] = (unsigned)(Rb * K + C) * 2u; }
    const size_t kstep = (size_t)(BK * 2);
    const size_t hstep = (size_t)HALF * K * 2;
    const size_t tstep = 2 * hstep;
    const unsigned ldsw = (unsigned)wid * 1024u;
    const int aoff = lds_byte(wr * 64 + fr, fq * 8), boff = lds_byte(wc * 32 + fr, fq * 8);
#define PG8_SA(b, h) (((b) * 2 + (h)) * HTB)
#define PG8_SB(b, h) ((4 + (b) * 2 + (h)) * HTB)
#define PG8_STAGE(bufoff, gbase, voff) do { _Pragma("unroll") for (int _i = 0; _i < 2; ++_i) \
        __builtin_amdgcn_global_load_lds((const unsigned*)((const char*)(gbase) + (voff)[_i]), (LAS unsigned*)(lds + (bufoff) + ldsw + _i * 8192), 16, 0, 0); } while (0)
#define PG8_LDA(dst, b, h) do { _Pragma("unroll") for (int m = 0; m < 4; ++m) _Pragma("unroll") for (int k = 0; k < 2; ++k) dst[m][k] = *(const LAS bf16x8*)(lds + PG8_SA(b, h) + aoff + m * 2048 + k * 1024); } while (0)
#define PG8_LDB(dst, b, h) do { _Pragma("unroll") for (int n = 0; n < 2; ++n) _Pragma("unroll") for (int k = 0; k < 2; ++k) dst[n][k] = *(const LAS bf16x8*)(lds + PG8_SB(b, h) + boff + n * 2048 + k * 1024); } while (0)
#define PG8_MMA(ai, bj, At, Bt) do { __builtin_amdgcn_s_setprio(1); _Pragma("unroll") for (int m = 0; m < 4; ++m) _Pragma("unroll") for (int n = 0; n < 2; ++n) _Pragma("unroll") for (int k = 0; k < 2; ++k) \
        acc[ai][bj][m][n] = __builtin_amdgcn_mfma_f32_16x16x32_bf16(Bt[n][k], At[m][k], acc[ai][bj][m][n], 0, 0, 0); __builtin_amdgcn_s_setprio(0); } while (0)
#define PG8_WAIT_V(n) asm volatile("s_waitcnt vmcnt(" #n ")" ::: "memory")
#define PG8_WAIT_L(n) asm volatile("s_waitcnt lgkmcnt(" #n ")" ::: "memory")
#define PG8_BAR __builtin_amdgcn_s_barrier()
#define PG8_SCHED __builtin_amdgcn_sched_barrier(0)
    Unit cur, nxt; int ui = 0;
    if (!S.next(0, cur)) return;
    f32x4 acc[2][2][4][2];
#pragma unroll
    for (int a = 0; a < 2; ++a)
#pragma unroll
        for (int b = 0; b < 2; ++b)
#pragma unroll
            for (int m = 0; m < 4; ++m)
#pragma unroll
                for (int n = 0; n < 2; ++n) acc[a][b][m][n] = (f32x4){0.f, 0.f, 0.f, 0.f};
    bf16x8 At[4][2], B0[2][2], B1[2][2];
    const char* cA = (const char*)(cur.kind ? g.A1 : g.A0) + (size_t)cur.pm * tstep; const char* cB = (const char*)(cur.kind ? g.B1 : g.B0) + (size_t)cur.pn * tstep;
    if constexpr (SP2) {
        PG8_STAGE(PG8_SB(0, 0), cB, voffB); PG8_STAGE(PG8_SB(0, 1), cB + hstep, voffB); PG8_STAGE(PG8_SA(0, 0), cA, voffA); PG8_STAGE(PG8_SA(0, 1), cA + hstep, voffA);
        if (wr == 1) PG8_BAR;
        PG8_WAIT_V(2); PG8_BAR;
        PG8_STAGE(PG8_SB(1, 0), cB + kstep, voffB); PG8_STAGE(PG8_SA(1, 0), cA + kstep, voffA); PG8_STAGE(PG8_SB(1, 1), cB + hstep + kstep, voffB);
        PG8_WAIT_V(6); PG8_BAR;
    } else {
    PG8_STAGE(PG8_SB(0, 0), cB, voffB); PG8_STAGE(PG8_SA(0, 0), cA, voffA); PG8_STAGE(PG8_SB(0, 1), cB + hstep, voffB); PG8_STAGE(PG8_SA(0, 1), cA + hstep, voffA);
    if (wr == 1) PG8_BAR;
    PG8_WAIT_V(4); PG8_BAR;
    PG8_STAGE(PG8_SB(1, 0), cB + kstep, voffB); PG8_STAGE(PG8_SA(1, 0), cA + kstep, voffA); PG8_STAGE(PG8_SB(1, 1), cB + hstep + kstep, voffB);
    PG8_WAIT_V(6); PG8_BAR;
    }
    for (;;) {
        const bool has_next = S.next(ui + 1, nxt);
        const char* nA = has_next ? (const char*)(nxt.kind ? g.A1 : g.A0) + (size_t)nxt.pm * tstep : cA; const char* nB = has_next ? (const char*)(nxt.kind ? g.B1 : g.B0) + (size_t)nxt.pn * tstep : cB;
        for (int t = 0; t < nt; t += 2) {
            const bool last = (t == nt - 2);
            const char* a1 = cA + (size_t)(t + 1) * kstep;
            const char* a2 = last ? nA : cA + (size_t)(t + 2) * kstep; const char* b2 = last ? nB : cB + (size_t)(t + 2) * kstep;
            const char* a3 = a2 + kstep; const char* b3 = b2 + kstep;
            if constexpr (SP2) {
            PG8_LDB(B0, 0, 0); PG8_LDB(B1, 0, 1); PG8_SCHED; PG8_LDA(At, 0, 0); PG8_STAGE(PG8_SA(1, 1), a1 + hstep, voffA);
            PG8_WAIT_V(8); PG8_WAIT_L(0); PG8_BAR; PG8_MMA(0, 0, At, B0); PG8_MMA(0, 1, At, B1); PG8_BAR; PG8_SCHED;
            PG8_LDA(At, 0, 1); PG8_STAGE(PG8_SB(0, 0), b2, voffB); PG8_STAGE(PG8_SB(0, 1), b2 + hstep, voffB); PG8_STAGE(PG8_SA(0, 0), a2, voffA);
            PG8_WAIT_V(8); PG8_WAIT_L(0); PG8_BAR; PG8_MMA(1, 0, At, B0); PG8_MMA(1, 1, At, B1); PG8_BAR; PG8_SCHED;
            PG8_LDB(B0, 1, 0); PG8_LDB(B1, 1, 1); PG8_SCHED; PG8_LDA(At, 1, 0); PG8_STAGE(PG8_SA(0, 1), a2 + hstep, voffA);
            PG8_WAIT_V(8); PG8_WAIT_L(0); PG8_BAR; PG8_MMA(0, 0, At, B0); PG8_MMA(0, 1, At, B1); PG8_BAR; PG8_SCHED;
            PG8_LDA(At, 1, 1); PG8_STAGE(PG8_SB(1, 0), b3, voffB); PG8_STAGE(PG8_SB(1, 1), b3 + hstep, voffB); PG8_STAGE(PG8_SA(1, 0), a3, voffA);
            PG8_WAIT_V(8); PG8_WAIT_L(0); PG8_BAR; PG8_MMA(1, 0, At, B0); PG8_MMA(1, 1, At, B1); PG8_BAR; PG8_SCHED;
            } else {
            PG8_LDB(B0, 0, 0); PG8_SCHED; PG8_LDA(At, 0, 0); PG8_STAGE(PG8_SA(1, 1), a1 + hstep, voffA);
            PG8_WAIT_L(8); PG8_BAR; PG8_WAIT_L(0); PG8_MMA(0, 0, At, B0); PG8_BAR; PG8_SCHED;
            PG8_LDB(B1, 0, 1); PG8_STAGE(PG8_SB(0, 0), b2, voffB);
            PG8_BAR; PG8_WAIT_L(0); PG8_MMA(0, 1, At, B1); PG8_BAR;
            PG8_LDA(At, 0, 1); PG8_STAGE(PG8_SA(0, 0), a2, voffA);
            PG8_BAR; PG8_WAIT_L(0); PG8_MMA(1, 0, At, B0); PG8_BAR; PG8_SCHED;
            PG8_STAGE(PG8_SB(0, 1), b2 + hstep, voffB);
            PG8_WAIT_V(6); PG8_BAR; PG8_MMA(1, 1, At, B1); PG8_BAR;
            PG8_LDB(B0, 1, 0); PG8_SCHED; PG8_LDA(At, 1, 0); PG8_STAGE(PG8_SA(0, 1), a2 + hstep, voffA);
            PG8_WAIT_L(8); PG8_BAR; PG8_WAIT_L(0); PG8_MMA(0, 0, At, B0); PG8_BAR; PG8_SCHED;
            PG8_LDB(B1, 1, 1); PG8_STAGE(PG8_SB(1, 0), b3, voffB);
            PG8_BAR; PG8_WAIT_L(0); PG8_MMA(0, 1, At, B1); PG8_BAR;
            PG8_LDA(At, 1, 1); PG8_STAGE(PG8_SA(1, 0), a3, voffA);
            PG8_BAR; PG8_WAIT_L(0); PG8_MMA(1, 0, At, B0); PG8_BAR; PG8_SCHED;
            PG8_STAGE(PG8_SB(1, 1), b3 + hstep, voffB);
            PG8_WAIT_V(6); PG8_BAR; PG8_MMA(1, 1, At, B1); PG8_BAR;
            }
        }
        if constexpr (ALIGN_EPI) { if (wr == 0) PG8_BAR; }
        const bool keep = E(acc, cur, wr, wc, fr, fq);
        if (!has_next) break;
        if (!keep) {
#pragma unroll
        for (int a = 0; a < 2; ++a)
#pragma unroll
            for (int b = 0; b < 2; ++b)
#pragma unroll
                for (int m = 0; m < 4; ++m)
#pragma unroll
                    for (int n = 0; n < 2; ++n) acc[a][b][m][n] = (f32x4){0.f, 0.f, 0.f, 0.f};
        }
        cur = nxt; cA = nA; cB = nB; ++ui;
        if constexpr (ALIGN_EPI) { if (wr == 1) PG8_BAR; }
    }
    PG8_WAIT_V(0);
    if constexpr (!ALIGN_EPI) { if (wr == 0) PG8_BAR; }
    PG8_BAR;
#undef PG8_SA
#undef PG8_SB
#undef PG8_STAGE
#undef PG8_LDA
#undef PG8_LDB
#undef PG8_MMA
#undef PG8_WAIT_V
#undef PG8_WAIT_L
#undef PG8_BAR
#undef PG8_SCHED
}
}

typedef unsigned long long ssq_t;
constexpr float SSQ_SCALE = 16777216.0f;
__device__ __forceinline__ ssq_t ssq_fix(float s) { return (ssq_t)(s * SSQ_SCALE + 0.5f); }
__device__ __forceinline__ float row_rstd(const ssq_t* ss, int row) { return rsqrtf((float)ss[row] * (1.0f / SSQ_SCALE) * (1.0f / D) + EPS); }

struct EpiGU {
    static constexpr bool PERM = true;
    const ssq_t* ss; bf16_t* act;
    __device__ __forceinline__ bool operator()(f32x4 (&acc)[2][2][4][2], const pg8::Unit& u, int wr, int wc, int fr, int fq) const {
        const int row0 = u.pm * 256 + wr * 64 + fr, col0 = u.pn * 128 + wc * 32 + 8 * fq;
#pragma unroll
        for (int ai = 0; ai < 2; ++ai)
#pragma unroll
            for (int m = 0; m < 4; ++m) {
                const int row = row0 + ai * 128 + m * 16; const float r = row_rstd(ss, row);
                float o[8];
#pragma unroll
                for (int n = 0; n < 2; ++n)
#pragma unroll
                    for (int j = 0; j < 4; ++j) { const float gv = acc[ai][0][m][n][j] * r, uv = acc[ai][1][m][n][j] * r; o[n * 4 + j] = gv * sigmoidf_(gv) * uv; }
                u32x4 w; w.x = pk2(o[0], o[1]); w.y = pk2(o[2], o[3]); w.z = pk2(o[4], o[5]); w.w = pk2(o[6], o[7]);
                *(u32x4*)(act + (size_t)row * FF + col0) = w;
            }
        return false;
    }
};
struct EpiRes {
    static constexpr bool PERM = false;
    const float* xin32; bf16_t* xb; ssq_t* ss_out; float scale;
    __device__ __forceinline__ bool operator()(f32x4 (&acc)[2][2][4][2], const pg8::Unit& u, int wr, int wc, int fr, int fq) const {
        const int row0 = u.pm * 256 + wr * 64 + fr, col0 = u.pn * 256 + wc * 32 + 4 * fq;
#pragma unroll
        for (int ai = 0; ai < 2; ++ai)
#pragma unroll
            for (int m = 0; m < 4; ++m) {
                const int row = row0 + ai * 128 + m * 16; float s = 0.f;
#pragma unroll
                for (int bj = 0; bj < 2; ++bj)
#pragma unroll
                    for (int n = 0; n < 2; ++n) {
                        const size_t off = (size_t)row * D + col0 + bj * 128 + n * 16;
                        f32x4 xv;
                        if (xin32) xv = *(const f32x4*)(xin32 + off);
                        else { const u32x2 wi = *(const u32x2*)(xb + off); xv = (f32x4){bf_lo(wi.x), bf_hi(wi.x), bf_lo(wi.y), bf_hi(wi.y)}; }
                        xv = xv + acc[ai][bj][m][n] * scale;
                        u32x2 w; w.x = pk2(xv[0], xv[1]); w.y = pk2(xv[2], xv[3]); *(u32x2*)(xb + off) = w;
                        const float r0 = bf_lo(w.x), r1 = bf_hi(w.x), r2 = bf_lo(w.y), r3 = bf_hi(w.y);
                        s += (r0 * r0 + r1 * r1) + (r2 * r2 + r3 * r3);
                    }
                s += __shfl_xor(s, 16); s += __shfl_xor(s, 32);
                if (fq == 0) __hip_atomic_fetch_add(ss_out + row, ssq_fix(s), __ATOMIC_RELAXED, __HIP_MEMORY_SCOPE_AGENT);
            }
        return false;
    }
};
struct EpiP {
    static constexpr bool PERM = true;
    const ssq_t* ss; bf16_t* P;
    __device__ __forceinline__ bool operator()(f32x4 (&acc)[2][2][4][2], const pg8::Unit& u, int wr, int wc, int fr, int fq) const {
        const int row0 = u.pm * 256 + wr * 64 + fr, col0 = u.pn * 256 + wc * 32 + 8 * fq;
#pragma unroll
        for (int ai = 0; ai < 2; ++ai)
#pragma unroll
            for (int m = 0; m < 4; ++m) {
                const int row = row0 + ai * 128 + m * 16; const float r = row_rstd(ss, row);
#pragma unroll
                for (int bj = 0; bj < 2; ++bj) {
                    const f32x4 v0 = acc[ai][bj][m][0] * r, v1 = acc[ai][bj][m][1] * r;
                    u32x4 w; w.x = pk2(v0[0], v0[1]); w.y = pk2(v0[2], v0[3]); w.z = pk2(v1[0], v1[1]); w.w = pk2(v1[2], v1[3]);
                    *(u32x4*)(P + (size_t)row * INC + col0 + bj * 128) = w;
                }
            }
        return false;
    }
};
struct EpiMerge {
    static constexpr bool PERM = true;
    const bf16_t* P; bf16_t* mg;
    __device__ __forceinline__ bool operator()(f32x4 (&acc)[2][2][4][2], const pg8::Unit& u, int wr, int wc, int fr, int fq) const {
        const int row0 = u.pm * 256 + wr * 64 + fr, col0 = u.pn * 256 + wc * 32 + 8 * fq;
#pragma unroll
        for (int ai = 0; ai < 2; ++ai)
#pragma unroll
            for (int m = 0; m < 4; ++m) {
                const int row = row0 + ai * 128 + m * 16;
#pragma unroll
                for (int bj = 0; bj < 2; ++bj) {
                    const int col = col0 + bj * 128;
                    const u32x4 gb = *(const u32x4*)(P + (size_t)row * INC + PC_GB + col);
                    if (u.kind == 0) {
                        const u32x4 ga = *(const u32x4*)(P + (size_t)row * INC + PC_GA + col);
#pragma unroll
                        for (int q = 0; q < 4; ++q) {
                            const float a0 = bf_lo(ga[q]), a1 = bf_hi(ga[q]), b0 = bf_lo(gb[q]), b1 = bf_hi(gb[q]);
                            const float r0 = (1.0f + fexp(-b0)) * __builtin_amdgcn_rcpf(1.0f + fexp(-a0));
                            const float r1 = (1.0f + fexp(-b1)) * __builtin_amdgcn_rcpf(1.0f + fexp(-a1));
                            acc[ai][bj][m][q >> 1][(q & 1) * 2 + 0] *= r0; acc[ai][bj][m][q >> 1][(q & 1) * 2 + 1] *= r1;
                        }
                    } else {
                        float o[8];
#pragma unroll
                        for (int q = 0; q < 4; ++q) {
                            o[2 * q] = acc[ai][bj][m][q >> 1][(q & 1) * 2 + 0] * sigmoidf_(bf_lo(gb[q]));
                            o[2 * q + 1] = acc[ai][bj][m][q >> 1][(q & 1) * 2 + 1] * sigmoidf_(bf_hi(gb[q]));
                        }
                        u32x4 w; w.x = pk2(o[0], o[1]); w.y = pk2(o[2], o[3]); w.z = pk2(o[4], o[5]); w.w = pk2(o[6], o[7]);
                        *(u32x4*)(mg + (size_t)row * D + col) = w;
                    }
                }
            }
        return u.kind == 0;
    }
};

__device__ __forceinline__ void p0_item(const float* W, const float* gain, int K, int N, bf16_t* WT, int mode, LAS float* scr, int item, int lane) {
    const int nblk = N / 64, kb = item / nblk, nb = item % nblk, k0 = 64 * kb, n0 = 64 * nb;
    const int kr = lane >> 4, nc = (lane & 15) * 4;
    f32x4 v[16];
#pragma unroll
    for (int i = 0; i < 16; ++i) v[i] = *(const f32x4*)(W + (size_t)(k0 + 4 * i + kr) * N + n0 + nc);
    if (gain) {
#pragma unroll
        for (int i = 0; i < 16; ++i) v[i] = v[i] * gain[k0 + 4 * i + kr];
    }
#pragma unroll
    for (int i = 0; i < 16; ++i) { LAS float* s = scr + (4 * i + kr) * 65 + nc; s[0] = v[i][0]; s[1] = v[i][1]; s[2] = v[i][2]; s[3] = v[i][3]; }
    LDS_WAIT();
    const int c = lane & 7;
    const int rbase = (mode == 0) ? n0 : ((n0 >> 7) * 256 + (mode == 2 ? 128 : 0) + (n0 & 127));
#pragma unroll
    for (int j = 0; j < 8; ++j) { const int n = (lane >> 3) + 8 * j; const LAS float* s = scr + (8 * c) * 65 + n;
        u32x4 o; o.x = pk2(s[0 * 65], s[1 * 65]); o.y = pk2(s[2 * 65], s[3 * 65]); o.z = pk2(s[4 * 65], s[5 * 65]); o.w = pk2(s[6 * 65], s[7 * 65]);
        *(u32x4*)(WT + (size_t)(rbase + n) * K + k0 + 8 * c) = o; }
    LDS_WAIT();
}

constexpr int I_FF = (D / 64) * (FF / 64), I_DN = (FF / 64) * (D / 64), I_IN = (D / 64) * (INC / 64), I_AB = (RGW / 64) * (D / 64), I_OUT = (D / 64) * (D / 64);
constexpr int I_A = 2 * I_FF + I_DN + I_IN;
constexpr int I_LAYER = 4 * I_FF + 2 * I_DN + I_IN + 2 * I_AB + I_OUT;
constexpr int I_P0 = 2 * I_FF;
constexpr int I_CUT2 = I_LAYER + 2 * I_FF;
__device__ __forceinline__ void convert_items(const Params& p, LAS unsigned char* lds, int lo, int hi, int wv, int nwv) {
    const int tid = opaque_tid(), lane = tid & 63, wave = tid >> 6;
    LAS float* scr = (LAS float*)(lds + wave * 16640);
    for (int it = lo + wv; it < hi; it += nwv) {
        const int l = it >= I_LAYER ? 1 : 0; int r = it - l * I_LAYER;
        bf16_t* wl = (bf16_t*)(p.ws + (size_t)l * SZ_LAYER);
        const float* W; const float* gain = nullptr; int K, N, mode = 0; size_t off;
        if (r < I_FF) { W = p.ffn1_wg + (size_t)l * D * FF; gain = p.ffn1_norm + l * D; K = D; N = FF; mode = 1; off = OFF_WGU1; }
        else if ((r -= I_FF) < I_FF) { W = p.ffn1_wu + (size_t)l * D * FF; gain = p.ffn1_norm + l * D; K = D; N = FF; mode = 2; off = OFF_WGU1; }
        else if ((r -= I_FF) < I_DN) { W = p.ffn1_wd + (size_t)l * D * FF; K = FF; N = D; off = OFF_WD1; }
        else if ((r -= I_DN) < I_IN) { W = p.w_in + (size_t)l * D * INC; gain = p.mix_norm + l * D; K = D; N = INC; off = OFF_WIN; }
        else if ((r -= I_IN) < I_AB) { W = p.wa + (size_t)l * RGW * D; K = RGW; N = D; off = OFF_WA; }
        else if ((r -= I_AB) < I_AB) { W = p.wb + (size_t)l * RGW * D; K = RGW; N = D; off = OFF_WB; }
        else if ((r -= I_AB) < I_OUT) { W = p.wout + (size_t)l * D * D; K = D; N = D; off = OFF_WOUT; }
        else if ((r -= I_OUT) < I_FF) { W = p.ffn2_wg + (size_t)l * D * FF; gain = p.ffn2_norm + l * D; K = D; N = FF; mode = 1; off = OFF_WGU2; }
        else if ((r -= I_FF) < I_FF) { W = p.ffn2_wu + (size_t)l * D * FF; gain = p.ffn2_norm + l * D; K = D; N = FF; mode = 2; off = OFF_WGU2; }
        else { r -= I_FF; W = p.ffn2_wd + (size_t)l * D * FF; K = FF; N = D; off = OFF_WD2; }
        p0_item(W, gain, K, N, (bf16_t*)((unsigned char*)wl + off), mode, scr, r, lane);
    }
}
__device__ __forceinline__ void tail_convert(const Params& p, LAS unsigned char* lds, int nunits, int G, int c, int lo, int hi) {
    const int rem = nunits % G, wave = opaque_tid() >> 6;
    if (rem != 0 && c < rem) return;
    convert_items(p, lds, lo, hi, (c - rem) * NWAVES + wave, (G - rem) * NWAVES);
}

__device__ __forceinline__ void p0_prologue(const Params& p, LAS unsigned char* lds, int G) {
    const int tid = opaque_tid(), lane = tid & 63, wave = tid >> 6;
    const int gw = blockIdx.x * NWAVES + wave, NGW = G * NWAVES;
    convert_items(p, lds, 0, I_P0, gw, NGW);
    ssq_t* ss = (ssq_t*)(p.ws + WS_SS); bf16_t* xb = (bf16_t*)(p.ws + WS_XB);
    for (int row = gw; row < T; row += NGW) {
        const f32x4* xr = (const f32x4*)(p.x + (size_t)row * D) + lane; u32x2* o = (u32x2*)(xb + (size_t)row * D) + lane; float s = 0.f;
#pragma unroll
        for (int j = 0; j < 8; ++j) { const f32x4 v = xr[64 * j]; s += (v[0] * v[0] + v[1] * v[1]) + (v[2] * v[2] + v[3] * v[3]); u32x2 w; w.x = pk2(v[0], v[1]); w.y = pk2(v[2], v[3]); o[64 * j] = w; }
        s = wave_sum(s); if (lane == 0) ss[row] = ssq_fix(s);
    }
    for (int i = blockIdx.x * NTHREADS + tid; i < 7 * T; i += G * NTHREADS) ss[T + i] = 0ull;
}

constexpr int H_QS = 272, H_TS = 144;
constexpr int HB_SZ = 62464, HB_QI = 0, HB_KI = 17408, HB_KIT = 34816, HB_VT = 53248;
constexpr int H_ST = 2 * HB_SZ, H_PM = H_ST + 17408, H_GT = H_PM + 9216;
static_assert(H_GT + 2 * 2048 <= LDS_BAR_OFF, "HGRN LDS image");
__device__ __forceinline__ void hgrn_chain(const Params& p, LAS unsigned char* lds, int layer, int chain, int dvh) {
    const int tid = opaque_tid(), lane = tid & 63, wave = __builtin_amdgcn_readfirstlane(tid >> 6), fr = lane & 15, fq = lane >> 4;
    const bf16_t* P = (const bf16_t*)(p.ws + WS_P);
    const int b = chain >> 4, h = (chain >> 1) & 7, dir = chain & 1;
    float* O = (float*)(p.ws + (dir ? WS_OB : WS_OF));
    const float* lbl = dir ? p.lbb : p.lbf;
    const int zc = (dir ? PC_ZB : PC_ZF) + h * 128;
    const int d = tid & 127, tg = tid >> 7;
    const int vs = tid & 63, vg = tid >> 6;
    float lb = 0.f;
    if (layer == 1) { const int ch = h * 128 + d; lb = sigmoidf_(lbl[RGW + ch] - lbl[ch]); }
    f32x4 Sacc[4];
#pragma unroll
    for (int i = 0; i < 4; ++i) Sacc[i] = (f32x4){0.f, 0.f, 0.f, 0.f};
    bf16_t zr[16], qr[16]; u32x4 vr0;
    float pb[16], kk_[16], qf[16]; u32x4 v0;
    const ptrdiff_t tstep_ = dir ? -(ptrdiff_t)INC : (ptrdiff_t)INC;
#define HG_TOK(c, j) ((size_t)b * SEQ + (dir ? ((SEQ / 64 - 1 - (c)) * 64 + 63 - (j)) : ((c) * 64 + (j))))
#define HG_LOAD(c) do { const bf16_t* zp_ = P + HG_TOK(c, tg * 16) * INC + zc + d; const bf16_t* qp_ = P + HG_TOK(c, tg * 16) * INC + PC_Q + h * 128 + d; \
        _Pragma("unroll") for (int i = 0; i < 16; ++i) { zr[i] = *zp_; qr[i] = *qp_; zp_ += tstep_; qp_ += tstep_; } \
        { const size_t tk = HG_TOK(c, vs); const bf16_t* vp = P + tk * INC + PC_I + h * 128 + dvh * 64 + vg * 8; vr0 = *(const u32x4*)vp; } } while (0)
#define HG_A1(g) do { LAS float* GT_ = (LAS float*)(lds + H_GT + (g) * 2048); float run = 1.f; \
        _Pragma("unroll") for (int i = 0; i < 16; ++i) { \
            const float z = fmaxf(bf1(zr[i]), -60.0f); const float e = fexp(-z), sg = __builtin_amdgcn_rcpf(1.0f + e); \
            const float f = lb + (1.0f - lb) * sg; kk_[i] = (1.0f - lb) * e * sg; run *= f; pb[i] = run; qf[i] = bf1(qr[i]); } \
        GT_[tg * 128 + d] = run; v0 = vr0; } while (0)
#define HG_A2(g, lb_) do { const LAS float* GT_ = (const LAS float*)(lds + H_GT + (g) * 2048); \
        const float g0 = GT_[d], g1 = GT_[128 + d], g2 = GT_[256 + d]; \
        const float den = (tg == 0) ? g0 * g1 : g1; \
        const float C = (tg >= 2) ? (tg == 3 ? g2 : 1.0f) : __builtin_amdgcn_rcpf(fmaxf(den, 1e-36f)); \
        unsigned kw[8]; \
        _Pragma("unroll") for (int i = 0; i < 16; i += 2) { \
            const float eq0 = fminf(fmaxf(pb[i] * C, 2.4e-35f), 4.15e34f), eq1 = fminf(fmaxf(pb[i + 1] * C, 2.4e-35f), 4.15e34f); \
            const float ek0 = __builtin_amdgcn_rcpf(eq0), ek1 = __builtin_amdgcn_rcpf(eq1); \
            const unsigned qw = pk2(qf[i] * eq0, qf[i + 1] * eq1); kw[i >> 1] = pk2(kk_[i] * ek0, kk_[i + 1] * ek1); \
            const int j = tg * 16 + i; \
            *(LAS bf16_t*)((lb_) + HB_QI + j * H_QS + d * 2) = (bf16_t)(qw & 0xffffu); *(LAS bf16_t*)((lb_) + HB_QI + (j + 1) * H_QS + d * 2) = (bf16_t)(qw >> 16); \
            *(LAS bf16_t*)((lb_) + HB_KI + j * H_QS + d * 2) = (bf16_t)(kw[i >> 1] & 0xffffu); *(LAS bf16_t*)((lb_) + HB_KI + (j + 1) * H_QS + d * 2) = (bf16_t)(kw[i >> 1] >> 16); } \
        u32x4 w0, w1; w0.x = kw[0]; w0.y = kw[1]; w0.z = kw[2]; w0.w = kw[3]; w1.x = kw[4]; w1.y = kw[5]; w1.z = kw[6]; w1.w = kw[7]; \
        *(LAS u32x4*)((lb_) + HB_KIT + d * H_TS + tg * 32) = w0; *(LAS u32x4*)((lb_) + HB_KIT + d * H_TS + tg * 32 + 16) = w1; \
        _Pragma("unroll") for (int q = 0; q < 4; ++q) { \
            *(LAS bf16_t*)((lb_) + HB_VT + (vg * 8 + 2 * q) * H_TS + vs * 2) = (bf16_t)(v0[q] & 0xffffu); *(LAS bf16_t*)((lb_) + HB_VT + (vg * 8 + 2 * q + 1) * H_TS + vs * 2) = (bf16_t)(v0[q] >> 16); } } while (0)
    HG_LOAD(0);
    HG_A1(0);
    HG_LOAD(1);
    LDS_BARRIER();
    HG_A2(0, lds);
    LDS_BARRIER();
    for (int c = 0; c < SEQ / 64; ++c) {
        const int cur = c & 1;
        LAS unsigned char* lc = lds + cur * HB_SZ;
        LAS unsigned char* ln = lds + (cur ^ 1) * HB_SZ;
        f32x4 eb, ec;
        {
            const LAS float* GT = (const LAS float*)(lds + H_GT + cur * 2048);
            const f32x4 g0 = *(const LAS f32x4*)(GT + wave * 16 + fq * 4), g1 = *(const LAS f32x4*)(GT + 128 + wave * 16 + fq * 4);
            const f32x4 g2 = *(const LAS f32x4*)(GT + 256 + wave * 16 + fq * 4), g3 = *(const LAS f32x4*)(GT + 384 + wave * 16 + fq * 4);
            eb = g0 * g1; ec = g2 * g3;
        }
#pragma unroll
        for (int dvt = 0; dvt < 4; ++dvt) {
            Sacc[dvt] = Sacc[dvt] * eb;
            u32x2 w; w.x = pk2(Sacc[dvt][0], Sacc[dvt][1]); w.y = pk2(Sacc[dvt][2], Sacc[dvt][3]);
            *(LAS u32x2*)(lds + H_ST + (dvt * 16 + fr) * H_QS + (wave * 16 + fq * 4) * 2) = w;
        }
        {
            const int tt = wave >> 1;
#pragma unroll
            for (int u = 0; u < 2; ++u) {
                const int st = (wave & 1) * 2 + u;
                f32x4 a4 = (f32x4){0.f, 0.f, 0.f, 0.f};
                if (st <= tt) {
#pragma unroll
                    for (int kk = 0; kk < 4; ++kk) {
                        const bf16x8 ka = *(const LAS bf16x8*)(lc + HB_KI + (st * 16 + fr) * H_QS + (kk * 32 + fq * 8) * 2);
                        const bf16x8 qb = *(const LAS bf16x8*)(lc + HB_QI + (tt * 16 + fr) * H_QS + (kk * 32 + fq * 8) * 2);
                        a4 = __builtin_amdgcn_mfma_f32_16x16x32_bf16(ka, qb, a4, 0, 0, 0);
                    }
                    const int t = tt * 16 + fr;
#pragma unroll
                    for (int j = 0; j < 4; ++j) { const int s = st * 16 + fq * 4 + j; a4[j] = (s <= t) ? a4[j] : 0.f; }
                }
                u32x2 w; w.x = pk2(a4[0], a4[1]); w.y = pk2(a4[2], a4[3]);
                *(LAS u32x2*)(lds + H_PM + (tt * 16 + fr) * H_TS + (st * 16 + fq * 4) * 2) = w;
            }
        }
        if (c + 1 < SEQ / 64) { HG_A1(cur ^ 1); if (c + 2 < SEQ / 64) HG_LOAD(c + 2); }
        LDS_BARRIER();
        {
            const int dvt = wave & 3;
            bf16x8 va[2], sa[4];
#pragma unroll
            for (int ks = 0; ks < 2; ++ks) va[ks] = *(const LAS bf16x8*)(lc + HB_VT + (dvt * 16 + fr) * H_TS + (ks * 32 + fq * 8) * 2);
#pragma unroll
            for (int kk = 0; kk < 4; ++kk) sa[kk] = *(const LAS bf16x8*)(lds + H_ST + (dvt * 16 + fr) * H_QS + (kk * 32 + fq * 8) * 2);
#pragma unroll
            for (int u = 0; u < 2; ++u) {
                const int tt = (wave >> 2) * 2 + u;
                f32x4 o4 = (f32x4){0.f, 0.f, 0.f, 0.f};
#pragma unroll
                for (int ks = 0; ks < 2; ++ks) { const bf16x8 pbf = *(const LAS bf16x8*)(lds + H_PM + (tt * 16 + fr) * H_TS + (ks * 32 + fq * 8) * 2); o4 = __builtin_amdgcn_mfma_f32_16x16x32_bf16(va[ks], pbf, o4, 0, 0, 0); }
#pragma unroll
                for (int kk = 0; kk < 4; ++kk) { const bf16x8 qb = *(const LAS bf16x8*)(lc + HB_QI + (tt * 16 + fr) * H_QS + (kk * 32 + fq * 8) * 2); o4 = __builtin_amdgcn_mfma_f32_16x16x32_bf16(sa[kk], qb, o4, 0, 0, 0); }
                *(f32x4*)(O + HG_TOK(c, tt * 16 + fr) * RGW + h * 128 + dvh * 64 + dvt * 16 + fq * 4) = o4;
            }
        }
        {
            bf16x8 ka[2];
#pragma unroll
            for (int ks = 0; ks < 2; ++ks) ka[ks] = *(const LAS bf16x8*)(lc + HB_KIT + (wave * 16 + fr) * H_TS + (ks * 32 + fq * 8) * 2);
#pragma unroll
            for (int dvt = 0; dvt < 4; ++dvt) {
#pragma unroll
                for (int ks = 0; ks < 2; ++ks) { const bf16x8 vb = *(const LAS bf16x8*)(lc + HB_VT + (dvt * 16 + fr) * H_TS + (ks * 32 + fq * 8) * 2); Sacc[dvt] = __builtin_amdgcn_mfma_f32_16x16x32_bf16(ka[ks], vb, Sacc[dvt], 0, 0, 0); }
                Sacc[dvt] = Sacc[dvt] * ec;
            }
        }
        if (c + 1 < SEQ / 64) HG_A2(cur ^ 1, ln);
        LDS_BARRIER();
    }
    __syncthreads();
#undef HG_A1
#undef HG_A2
#undef HG_LOAD
#undef HG_TOK
}

__device__ __forceinline__ void post_phase(const Params& p, int G, int layer) {
    const int tid = opaque_tid(), lane = tid & 63, wave = tid >> 6;
    const bf16_t* P = (const bf16_t*)(p.ws + WS_P); const float* OF = (const float*)(p.ws + WS_OF); const float* OB = (const float*)(p.ws + WS_OB);
    bf16_t* OA = (bf16_t*)(p.ws + WS_OA); const float* gain = p.rg_norm + layer * RGW;
    for (int pr = blockIdx.x * NWAVES + wave; pr < T * 8; pr += G * NWAVES) {
        const int tok = pr >> 3, h = pr & 7; const size_t off = (size_t)tok * RGW + h * 128 + 2 * lane;
        const f32x2 a = *(const f32x2*)(OF + off), bq = *(const f32x2*)(OB + off);
        const float o0 = a[0] + bq[0], o1 = a[1] + bq[1];
        const float s = wave_sum(o0 * o0 + o1 * o1); const float r = rsqrtf(s * (1.0f / 128.0f) + EPS);
        const unsigned gw_ = *(const unsigned*)(P + (size_t)tok * INC + PC_G + h * 128 + 2 * lane);
        const float g0 = bf_lo(gw_), g1 = bf_hi(gw_);
        const f32x2 gn = *(const f32x2*)(gain + h * 128 + 2 * lane);
        *(unsigned*)(OA + off) = pk2(o0 * r * gn[0] * (g0 * sigmoidf_(g0)), o1 * r * gn[1] * (g1 * sigmoidf_(g1)));
    }
}

constexpr int KST = 272;
constexpr int VST = 136;
__device__ __forceinline__ void attn_phase(const Params& p, LAS unsigned char* lds, int first, int stride, int layer) {
    const int tid = opaque_tid(), lane = tid & 63, wave = tid >> 6, fr = lane & 15, fq = lane >> 4;
    const bf16_t* P = (const bf16_t*)(p.ws + WS_P); bf16_t* OT = (bf16_t*)(p.ws + WS_OT);
    LAS unsigned char* Kt = lds;
    LAS unsigned char* Vt = lds + 64 * KST;
    for (int item = first; item < 4 * 16 * 8; item += stride) {
        const int h = item & 7, qb = (item >> 3) & 15, b = item >> 7, kvh = h >> 2;
        const float slope = exp2f(-(float)(h + 1)), sinkv = p.sink[layer * 8 + h];
        const int q0 = qb * 128, qw = q0 + wave * 16, qt = qw + fr;
        const size_t tokq = (size_t)b * SEQ + qt;
        bf16x8 Qf[4];
#pragma unroll
        for (int kk = 0; kk < 4; ++kk) Qf[kk] = *(const bf16x8*)(P + tokq * INC + PC_AQ + h * 128 + kk * 32 + fq * 8);
        f32x4 Oa[8];
#pragma unroll
        for (int i = 0; i < 8; ++i) Oa[i] = (f32x4){0.f, 0.f, 0.f, 0.f};
        float mrun = sinkv, lrun = 1.0f;
        const int kb_lo = (q0 - 128 < 0) ? 2 : 0, kb_hi = (q0 + 256 > SEQ) ? 4 : 6;
        const int skey = tid >> 4, sd0 = (tid & 15) * 8;
        u32x4 kreg[2], vreg[2];
#define AT_LOAD(kb_) do { const int k0_ = q0 - 128 + (kb_) * 64; _Pragma("unroll") for (int i = 0; i < 2; ++i) { const size_t tk = (size_t)b * SEQ + k0_ + skey + i * 32; \
            kreg[i] = *(const u32x4*)(P + tk * INC + PC_AK + kvh * 128 + sd0); vreg[i] = *(const u32x4*)(P + tk * INC + PC_AV + kvh * 128 + sd0); } } while (0)
        AT_LOAD(kb_lo);
        for (int kb = kb_lo; kb < kb_hi; ++kb) {
            const int k0 = q0 - 128 + kb * 64;
            __syncthreads();
#pragma unroll
            for (int i = 0; i < 2; ++i) {
                const int key = skey + i * 32;
                *(LAS u32x4*)(Kt + key * KST + sd0 * 2) = kreg[i];
#pragma unroll
                for (int q = 0; q < 4; ++q) {
                    *(LAS bf16_t*)(Vt + (sd0 + 2 * q) * VST + key * 2) = (bf16_t)(vreg[i][q] & 0xffffu);
                    *(LAS bf16_t*)(Vt + (sd0 + 2 * q + 1) * VST + key * 2) = (bf16_t)(vreg[i][q] >> 16);
                }
            }
            __syncthreads();
            if (kb + 1 < kb_hi) AT_LOAD(kb + 1);
            if (k0 + 63 < qw - 128 || k0 > qw + 15 + 128) continue;
            f32x4 Sa[4];
#pragma unroll
            for (int t = 0; t < 4; ++t) {
                Sa[t] = (f32x4){0.f, 0.f, 0.f, 0.f};
#pragma unroll
                for (int kk = 0; kk < 4; ++kk) {
                    const bf16x8 kf = *(const LAS bf16x8*)(Kt + (t * 16 + fr) * KST + (kk * 32 + fq * 8) * 2);
                    Sa[t] = __builtin_amdgcn_mfma_f32_16x16x32_bf16(kf, Qf[kk], Sa[t], 0, 0, 0);
                }
            }
            float mloc = -INFINITY;
#pragma unroll
            for (int t = 0; t < 4; ++t)
#pragma unroll
                for (int j = 0; j < 4; ++j) {
                    const int kt = k0 + t * 16 + fq * 4 + j; const int rel = kt - qt; const int ar = rel < 0 ? -rel : rel;
                    float s = Sa[t][j] * 0.08838834764831845f - slope * (float)ar;
                    s = (ar <= 128) ? s : -INFINITY;
                    Sa[t][j] = s; mloc = fmaxf(mloc, s);
                }
            mloc = fmaxf(mloc, __shfl_xor(mloc, 16)); mloc = fmaxf(mloc, __shfl_xor(mloc, 32));
            const float mnew = fmaxf(mrun, mloc), alpha = fexp(mrun - mnew);
            float lsum = 0.f;
#pragma unroll
            for (int t = 0; t < 4; ++t)
#pragma unroll
                for (int j = 0; j < 4; ++j) { const float e = fexp(Sa[t][j] - mnew); Sa[t][j] = e; lsum += e; }
            lsum += __shfl_xor(lsum, 16); lsum += __shfl_xor(lsum, 32);
            lrun = lrun * alpha + lsum; mrun = mnew;
#pragma unroll
            for (int i = 0; i < 8; ++i) Oa[i] = Oa[i] * alpha;
            bf16x8 Pf[2];
#pragma unroll
            for (int s2 = 0; s2 < 2; ++s2) {
                u32x4 w; w.x = pk2(Sa[2 * s2][0], Sa[2 * s2][1]); w.y = pk2(Sa[2 * s2][2], Sa[2 * s2][3]); w.z = pk2(Sa[2 * s2 + 1][0], Sa[2 * s2 + 1][1]); w.w = pk2(Sa[2 * s2 + 1][2], Sa[2 * s2 + 1][3]);
                Pf[s2] = __builtin_bit_cast(bf16x8, w);
            }
#pragma unroll
            for (int dt = 0; dt < 8; ++dt)
#pragma unroll
                for (int s2 = 0; s2 < 2; ++s2) {
                    const LAS unsigned char* vp = Vt + (dt * 16 + fr) * VST + (s2 * 32 + fq * 4) * 2;
                    const u32x2 lo = *(const LAS u32x2*)vp, hi = *(const LAS u32x2*)(vp + 32);
                    u32x4 w; w.x = lo.x; w.y = lo.y; w.z = hi.x; w.w = hi.y;
                    Oa[dt] = __builtin_amdgcn_mfma_f32_16x16x32_bf16(__builtin_bit_cast(bf16x8, w), Pf[s2], Oa[dt], 0, 0, 0);
                }
        }
        const float inv = 1.0f / lrun;
#pragma unroll
        for (int dt = 0; dt < 8; ++dt) {
            u32x2 w; w.x = pk2(Oa[dt][0] * inv, Oa[dt][1] * inv); w.y = pk2(Oa[dt][2] * inv, Oa[dt][3] * inv);
            *(u32x2*)(OT + tokq * RGW + h * 128 + dt * 16 + fq * 4) = w;
        }
    }
}

__device__ __forceinline__ void final_phase(const Params& p, int G) {
    const int tid = opaque_tid(), lane = tid & 63, wave = tid >> 6;
    const bf16_t* XBp = (const bf16_t*)(p.ws + WS_XB); const ssq_t* ss = (const ssq_t*)(p.ws + WS_SS) + 6 * T;
    for (int row = blockIdx.x * NWAVES + wave; row < T; row += G * NWAVES) {
        const float r = row_rstd(ss, row);
        const u32x2* xr = (const u32x2*)(XBp + (size_t)row * D) + lane; const f32x4* gr = (const f32x4*)p.final_norm + lane; f32x4* o = (f32x4*)(p.out + (size_t)row * D) + lane;
#pragma unroll
        for (int j = 0; j < 8; ++j) { const u32x2 w = xr[64 * j]; const f32x4 xv = (f32x4){bf_lo(w.x), bf_hi(w.x), bf_lo(w.y), bf_hi(w.y)}; o[64 * j] = xv * r * gr[64 * j]; }
    }
}

__global__ void __launch_bounds__(NTHREADS, 2) fwd_megakernel(Params p) {
    extern __shared__ __attribute__((aligned(16))) unsigned char lds_raw[];
    LAS unsigned char* lds = (LAS unsigned char*)lds_raw;
    cg::grid_group grid = cg::this_grid();
    if (threadIdx.x < 4) ((LAS unsigned*)(lds + LDS_BAR_OFF))[threadIdx.x] = 0u;
    __syncthreads();
    XcdBarrier xbar = xcd_barrier_post((unsigned*)(p.ws + WS_BAR), (volatile LAS unsigned*)(lds + LDS_BAR_OFF));
    if (p.ws == nullptr) grid.sync();
#define GSYNC() xcd_barrier(xbar)
    const int G = gridDim.x, c = blockIdx.x;
    unsigned char* ws = p.ws;
    float* X = (float*)(ws + WS_X); bf16_t* XB = (bf16_t*)(ws + WS_XB); ssq_t* SS = (ssq_t*)(ws + WS_SS);
    bf16_t* ACT = (bf16_t*)(ws + WS_ACT); bf16_t* Pb = (bf16_t*)(ws + WS_P);
    bf16_t* OA = (bf16_t*)(ws + WS_OA); bf16_t* OT = (bf16_t*)(ws + WS_OT); bf16_t* MG = (bf16_t*)(ws + WS_MG);

#ifndef PHMASK
#define PHMASK 0xffff
#endif
#define PH(n) ((PHMASK >> (n)) & 1)
#if PH(0)
    p0_prologue(p, lds, G);
#endif
    GSYNC();
#pragma unroll 1
    for (int l = 0; l < 2; ++l) {
        const unsigned char* wl = ws + (size_t)l * SZ_LAYER;
        const ssq_t* ss_ffn1 = SS + (3 * l + 0) * T; ssq_t* ss_mix = SS + (3 * l + 1) * T; ssq_t* ss_ffn2 = SS + (3 * l + 2) * T; ssq_t* ss_next = SS + (3 * l + 3) * T;
#if PH(1)
        { pg8::Gemm g{XB, (const bf16_t*)(wl + OFF_WGU1), XB, (const bf16_t*)(wl + OFF_WGU1), T, 2 * FF, D}; pg8::StaticOrder S; S.init(T, 2 * FF, G, c);
          EpiGU E{ss_ffn1, ACT}; pg8::gemm_phase(lds, g, S, E); }
        if (l == 0) tail_convert(p, lds, (T / 256) * (2 * FF / 256), G, c, I_P0, I_A);
#endif
        GSYNC();
#if PH(2)
        { pg8::Gemm g{ACT, (const bf16_t*)(wl + OFF_WD1), ACT, (const bf16_t*)(wl + OFF_WD1), T, D, FF}; pg8::StaticOrder S; S.init(T, D, G, c);
          EpiRes E{l == 0 ? p.x : nullptr, XB, ss_mix, 0.5f}; pg8::gemm_phase(lds, g, S, E); }
#endif
        GSYNC();
#if PH(3)
        { pg8::Gemm g{XB, (const bf16_t*)(wl + OFF_WIN), XB, (const bf16_t*)(wl + OFF_WIN), T, INC, D}; pg8::StaticOrder S; S.init(T, INC, G, c);
          EpiP E{ss_mix, Pb}; pg8::gemm_phase(lds, g, S, E); }
        tail_convert(p, lds, (T / 256) * (INC / 256), G, c, l * I_LAYER + I_A, (l + 1) * I_LAYER);
#endif
        GSYNC();
#if PH(4)
        { const int hw = (G >= 256) ? 128 : 0;
          if (hw == 0 || c < hw) for (int ch = c; ch < 128; ch += (hw ? 128 : G)) hgrn_chain(p, lds, l, ((ch >> 4) << 3) | (ch & 7), (ch >> 3) & 1);
          if (c >= hw) { attn_phase(p, lds, c - hw, G - hw, l); __syncthreads(); if (l == 0) convert_items(p, lds, I_LAYER, I_CUT2, (c - hw) * NWAVES + (opaque_tid() >> 6), (G - hw) * NWAVES); } }
#endif
        GSYNC();
#if PH(6)
        post_phase(p, G, l);
#endif
        GSYNC();
#if PH(7)
        { pg8::Gemm g{OA, (const bf16_t*)(wl + OFF_WA), OT, (const bf16_t*)(wl + OFF_WB), T, D, RGW}; pg8::PairOrder S; S.init(T, D, G, c);
          EpiMerge E{Pb, MG}; pg8::gemm_phase(lds, g, S, E); }
#endif
        GSYNC();
#if PH(8)
        { pg8::Gemm g{MG, (const bf16_t*)(wl + OFF_WOUT), MG, (const bf16_t*)(wl + OFF_WOUT), T, D, D}; pg8::StaticOrder S; S.init(T, D, G, c);
          EpiRes E{nullptr, XB, ss_ffn2, 1.0f}; pg8::gemm_phase(lds, g, S, E); }
#endif
        GSYNC();
#if PH(9)
        { pg8::Gemm g{XB, (const bf16_t*)(wl + OFF_WGU2), XB, (const bf16_t*)(wl + OFF_WGU2), T, 2 * FF, D}; pg8::StaticOrder S; S.init(T, 2 * FF, G, c);
          EpiGU E{ss_ffn2, ACT}; pg8::gemm_phase(lds, g, S, E); }
        if (l == 0) tail_convert(p, lds, (T / 256) * (2 * FF / 256), G, c, I_CUT2, I_LAYER + I_A);
#endif
        GSYNC();
#if PH(10)
        { pg8::Gemm g{ACT, (const bf16_t*)(wl + OFF_WD2), ACT, (const bf16_t*)(wl + OFF_WD2), T, D, FF}; pg8::StaticOrder S; S.init(T, D, G, c);
          EpiRes E{nullptr, XB, ss_next, 0.5f}; pg8::gemm_phase(lds, g, S, E); }
#endif
        GSYNC();
    }
#if PH(11)
    final_phase(p, G);
#endif
}

extern "C" void kernel_launch(void* const* d_in, const int* in_sizes, int n_in, void* d_out, int out_size, void* d_ws, size_t ws_size, hipStream_t stream) {
    static int grid_blocks = 0;
    if (grid_blocks == 0) {
        if (n_in != 19 || ws_size < WS_END) { fprintf(stderr, "kernel_launch: unexpected n_in %d / ws_size %zu (need %zu)\n", n_in, ws_size, (size_t)WS_END); grid_blocks = -1; return; }
        int dev = 0, cus = 0, per_cu = 0;
        hipGetDevice(&dev);
        hipDeviceGetAttribute(&cus, hipDeviceAttributeMultiprocessorCount, dev);
        hipFuncSetAttribute((const void*)fwd_megakernel, hipFuncAttributeMaxDynamicSharedMemorySize, LDS_BYTES);
        hipOccupancyMaxActiveBlocksPerMultiprocessor(&per_cu, (const void*)fwd_megakernel, NTHREADS, LDS_BYTES);
        if (per_cu < 1) { fprintf(stderr, "kernel_launch: occupancy query says %d blocks/CU\n", per_cu); per_cu = 1; }
        grid_blocks = cus * 1;
    }
    if (grid_blocks < 0) return;
    Params p{};
    p.x = (const float*)d_in[0]; p.ffn1_norm = (const float*)d_in[1]; p.ffn1_wg = (const float*)d_in[2]; p.ffn1_wu = (const float*)d_in[3]; p.ffn1_wd = (const float*)d_in[4];
    p.mix_norm = (const float*)d_in[5]; p.w_in = (const float*)d_in[6]; p.lbf = (const float*)d_in[7]; p.lbb = (const float*)d_in[8]; p.rg_norm = (const float*)d_in[9];
    p.sink = (const float*)d_in[10]; p.wa = (const float*)d_in[11]; p.wb = (const float*)d_in[12]; p.wout = (const float*)d_in[13];
    p.ffn2_norm = (const float*)d_in[14]; p.ffn2_wg = (const float*)d_in[15]; p.ffn2_wu = (const float*)d_in[16]; p.ffn2_wd = (const float*)d_in[17]; p.final_norm = (const float*)d_in[18];
    p.out = (float*)d_out; p.ws = (unsigned char*)d_ws;
    if (hipMemsetAsync((char*)d_ws + WS_BAR, 0, 16384, stream) != hipSuccess) { fprintf(stderr, "kernel_launch: memset failed\n"); return; }
    void* args[] = {&p};
    hipError_t e = hipLaunchCooperativeKernel((const void*)fwd_megakernel, dim3(grid_blocks), dim3(NTHREADS), args, LDS_BYTES, stream);
    if (e != hipSuccess) fprintf(stderr, "cooperative launch failed: %s (grid %d)\n", hipGetErrorString(e), grid_blocks);
}
```

```cpp
#include <hip/hip_runtime.h>
#include <hip/hip_cooperative_groups.h>
#include <cstdio>
namespace cg = cooperative_groups;

#define LAS __attribute__((address_space(3)))
typedef unsigned short bf16_t;
typedef short bf16x8 __attribute__((ext_vector_type(8)));
typedef short bf16x4 __attribute__((ext_vector_type(4)));
typedef float f32x4 __attribute__((ext_vector_type(4)));
typedef float f32x2 __attribute__((ext_vector_type(2)));
typedef unsigned u32x4 __attribute__((ext_vector_type(4)));
typedef unsigned u32x2 __attribute__((ext_vector_type(2)));

constexpr int T = 8192, D = 2048, FF = 5632, INC = 10752, SEQ = 2048, RGW = 1024;
constexpr float EPS = 1e-6f;
constexpr int NTHREADS = 512, NWAVES = 8;
constexpr int LDS_BAR_OFF = 155648;
constexpr int LDS_BYTES = LDS_BAR_OFF + 16;

constexpr int PC_Q = 0, PC_I = 1024, PC_ZF = 2048, PC_ZB = 3072, PC_G = 4096, PC_AQ = 5120, PC_AK = 6144, PC_AV = 6400, PC_GA = 6656, PC_GB = 8704;

constexpr size_t SZ_WGU = (size_t)2 * FF * D * 2, SZ_WD = (size_t)D * FF * 2, SZ_WIN = (size_t)INC * D * 2, SZ_WAB = (size_t)D * RGW * 2, SZ_WOUT = (size_t)D * D * 2;
constexpr size_t OFF_WGU1 = 0, OFF_WD1 = OFF_WGU1 + SZ_WGU, OFF_WIN = OFF_WD1 + SZ_WD, OFF_WA = OFF_WIN + SZ_WIN, OFF_WB = OFF_WA + SZ_WAB, OFF_WOUT = OFF_WB + SZ_WAB,
                 OFF_WGU2 = OFF_WOUT + SZ_WOUT, OFF_WD2 = OFF_WGU2 + SZ_WGU, SZ_LAYER = OFF_WD2 + SZ_WD;
constexpr size_t WS_X = 2 * SZ_LAYER, WS_XB = WS_X + (size_t)T * D * 4, WS_SS = WS_XB + (size_t)T * D * 2, WS_BAR = WS_SS + (size_t)8 * T * 8, WS_REG = WS_BAR + 16384;
constexpr size_t WS_ACT = WS_REG;
constexpr size_t WS_P = WS_REG;
constexpr size_t WS_OF = WS_P + (size_t)T * INC * 2;
constexpr size_t WS_OB = WS_OF + (size_t)T * RGW * 4;
constexpr size_t WS_OA = WS_OB + (size_t)T * RGW * 4;
constexpr size_t WS_OT = WS_OA + (size_t)T * RGW * 2;
constexpr size_t WS_MG = WS_OT + (size_t)T * RGW * 2;
constexpr size_t WS_END = WS_MG + (size_t)T * D * 2;

struct Params {
    const float* x; const float* ffn1_norm; const float* ffn1_wg; const float* ffn1_wu; const float* ffn1_wd; const float* mix_norm; const float* w_in;
    const float* lbf; const float* lbb; const float* rg_norm; const float* sink; const float* wa; const float* wb; const float* wout;
    const float* ffn2_norm; const float* ffn2_wg; const float* ffn2_wu; const float* ffn2_wd; const float* final_norm;
    float* out; unsigned char* ws;
};

__device__ __forceinline__ unsigned pk2(float lo, float hi) { unsigned r; asm("v_cvt_pk_bf16_f32 %0, %1, %2" : "=v"(r) : "v"(lo), "v"(hi)); return r; }
__device__ __forceinline__ float bf_lo(unsigned w) { return __uint_as_float(w << 16); }
__device__ __forceinline__ float bf_hi(unsigned w) { return __uint_as_float(w & 0xffff0000u); }
__device__ __forceinline__ float bf1(bf16_t w) { return __uint_as_float(((unsigned)w) << 16); }
__device__ __forceinline__ float wave_sum(float v) {
#pragma unroll
    for (int o = 1; o < 64; o <<= 1) v += __shfl_xor(v, o);
    return v;
}
__device__ __forceinline__ float fexp(float v) { return __builtin_amdgcn_exp2f(v * 1.4426950408889634f); }
__device__ __forceinline__ float flog(float v) { return __builtin_amdgcn_logf(v) * 0.6931471805599453f; }
__device__ __forceinline__ float sigmoidf_(float v) { return __builtin_amdgcn_rcpf(1.0f + fexp(-v)); }
#define LDS_WAIT() asm volatile("s_waitcnt lgkmcnt(0)" ::: "memory")
#define LDS_BARRIER() do { asm volatile("s_waitcnt lgkmcnt(0)" ::: "memory"); __builtin_amdgcn_s_barrier(); asm volatile("" ::: "memory"); } while (0)
__device__ __forceinline__ int opaque_tid() { int t = threadIdx.x; asm volatile("" : "+v"(t)); return t; }


#define XB_TMO      128
#define XB_XCNT(j)  (256  + 64 * (j))
#define XB_XSUB(j)  (1280 + 64 * (j))
#define XB_XGEN(j)  (2304 + 64 * (j))
#define XB_TOP      3328
#define XB_TOPGEN   3392
#define XCD_BAR_WORDS 3456
#define XB_SPIN_CAP (1u << 22)
__device__ __forceinline__ unsigned xb_ld(unsigned* p)              { return __hip_atomic_load(p, __ATOMIC_RELAXED, __HIP_MEMORY_SCOPE_AGENT); }
__device__ __forceinline__ unsigned xb_add(unsigned* p, unsigned v) { return __hip_atomic_fetch_add(p, v, __ATOMIC_RELAXED, __HIP_MEMORY_SCOPE_AGENT); }
__device__ __forceinline__ unsigned xb_xcc_id() { return (unsigned)__builtin_amdgcn_s_getreg((3 << 11) | 20) & 0xFu; }
#define XB_SPIN(cond, bar) do { unsigned _sp = 0; while (cond) { __builtin_amdgcn_s_sleep(1); \
    if ((++_sp & 255u) == 0u) { if (xb_ld(&(bar)[XB_TMO])) break; if (_sp > XB_SPIN_CAP) { atomicAdd(&(bar)[XB_TMO], 1u); break; } } } } while (0)
struct XcdBarrier { unsigned* bar; unsigned x; volatile LAS unsigned* st; };
__device__ __forceinline__ XcdBarrier xcd_barrier_post(unsigned* bar, volatile LAS unsigned* st) {
    XcdBarrier b; b.bar = bar; b.x = xb_xcc_id(); b.st = st;
    if (threadIdx.x == 0) (void)xb_add(&bar[XB_XCNT(b.x)], 1u);
    return b;
}
__device__ __forceinline__ void xcd_barrier_complete(unsigned* bar, unsigned x, unsigned& nloc, unsigned& nx) {
    const unsigned G = gridDim.x * gridDim.y * gridDim.z;
    unsigned sum, cnt, mine, sp = 0u;
    for (;;) {
        sum = 0u; cnt = 0u; mine = 0u;
#pragma unroll
        for (unsigned j = 0; j < 16; ++j) { const unsigned c = xb_ld(&bar[XB_XCNT(j)]); sum += c; cnt += (c > 0u) ? 1u : 0u; mine = (j == x) ? c : mine; }
        if (sum == G) break;
        __builtin_amdgcn_s_sleep(1);
        if ((++sp & 255u) == 0u) { if (xb_ld(&bar[XB_TMO])) break; if (sp > XB_SPIN_CAP) { atomicAdd(&bar[XB_TMO], 1u); break; } }
    }
    nloc = mine > 0u ? mine : 1u; nx = cnt > 0u ? cnt : 1u;
}
__device__ __forceinline__ void xcd_barrier(const XcdBarrier& b) {
    asm volatile("s_waitcnt vmcnt(0)" ::: "memory");
    __syncthreads();
    if (threadIdx.x == 0) {
        unsigned* bar = b.bar; unsigned bx = b.x; asm volatile("" : "+s"(bx));
        __builtin_amdgcn_s_waitcnt(0);
        unsigned nloc = b.st[0], nx = b.st[1];
        if (nloc == 0u) { xcd_barrier_complete(bar, bx, nloc, nx); b.st[0] = nloc; b.st[1] = nx; }
        const unsigned old = xb_add(&bar[XB_XSUB(bx)], 1u);
        const unsigned gen = old / nloc;
        if (old + 1u == (gen + 1u) * nloc) {
            __builtin_amdgcn_fence(__ATOMIC_RELEASE, "agent");
            asm volatile("s_waitcnt vmcnt(0)" ::: "memory");
            const unsigned og = xb_add(&bar[XB_TOP], 1u);
            const unsigned tg = og / nx;
            if (og + 1u == (tg + 1u) * nx) xb_add(&bar[XB_TOPGEN], 1u);
            else XB_SPIN(xb_ld(&bar[XB_TOPGEN]) == tg, bar);
            __builtin_amdgcn_fence(__ATOMIC_ACQUIRE, "agent");
            xb_add(&bar[XB_XGEN(bx)], 1u);
            asm volatile("s_waitcnt vmcnt(0)" ::: "memory");
        } else {
            XB_SPIN(xb_ld(&bar[XB_XGEN(bx)]) == gen, bar);
            __builtin_amdgcn_fence(__ATOMIC_ACQUIRE, "agent");
            asm volatile("s_waitcnt vmcnt(0)" ::: "memory");
        }
    }
    __syncthreads();
}

namespace pg8 {
constexpr int BM = 256, BK = 64, HALF = 128, HTB = HALF * BK * 2, STAGE_BYTES = 8 * HTB, NXCD = 8, WGM = 8;
__host__ __device__ __forceinline__ int lds_byte(int r, int c) { const int st = (r >> 4) * 2 + (c >> 5), rr = r & 15, cc = c & 31, ob = rr * 64 + cc * 2; return st * 1024 + (ob ^ (((ob >> 9) & 1) << 5)); }
__host__ __device__ __forceinline__ void stage_rc(int b, int& R, int& C) { const int st = b / 1024, sb = b % 1024, swz = sb ^ (((sb >> 9) & 1) << 5); R = (st >> 1) * 16 + swz / 64; C = (st & 1) * 32 + (swz % 64) / 2; }
__host__ __device__ __forceinline__ int perm32(int rho) { const int n = rho >> 4, i = rho & 15; return 8 * (i >> 2) + 4 * n + (i & 3); }

struct Unit { int pm, pn, kind; };
struct Gemm { const bf16_t* A0; const bf16_t* B0; const bf16_t* A1; const bf16_t* B1; int M, N, K; };

struct StaticOrder {
    int nM, nN, nwg, G, c;
    __device__ void init(int M, int N, int G_, int c_) { nM = M / BM; nN = N / BM; nwg = nM * nN; G = G_; c = c_; }
    __device__ bool next(int i, Unit& u) const {
        const long L = (long)i * G + c; if (L >= nwg) return false;
        int wgid = (int)L; { const int q = nwg / NXCD, r = nwg % NXCD, xcd = wgid % NXCD, off = wgid / NXCD; wgid = (xcd < r ? xcd * (q + 1) : r * (q + 1) + (xcd - r) * q) + off; }
        const int nig = WGM * nN, gid = wgid / nig, fm = gid * WGM, gsz = (nM - fm) < WGM ? (nM - fm) : WGM;
        u.pm = fm + ((wgid % nig) % gsz); u.pn = (wgid % nig) / gsz; u.kind = 0; return true;
    }
};
struct PairOrder {
    StaticOrder so;
    __device__ void init(int M, int N, int G_, int c_) { so.init(M, N, G_, c_); }
    __device__ bool next(int i, Unit& u) const { if (!so.next(i >> 1, u)) return false; u.kind = i & 1; return true; }
};

template <class Epi, class Sched, bool ALIGN_EPI = true, bool SP2 = true>
__device__ __forceinline__ void gemm_phase(LAS unsigned char* lds, const Gemm g, const Sched& S, const Epi& E) {
    const int tid = opaque_tid(), wid = __builtin_amdgcn_readfirstlane(tid >> 6), lane = tid & 63, wr = wid >> 2, wc = wid & 3, fr = lane & 15, fq = lane >> 4;
    const int K = g.K, nt = K / BK;
    unsigned voffA[2], voffB[2];
#pragma unroll
    for (int i = 0; i < 2; ++i) { int R, C; stage_rc(tid * 16 + i * 8192, R, C); const int Rb = Epi::PERM ? ((R & ~31) + perm32(R & 31)) : R;
        voffA[i] = (unsigned)(R * K + C) * 2u; voffB[i] = (unsigned)(Rb * K + C) * 2u; }
    const size_t kstep = (size_t)(BK * 2);
    const size_t hstep = (size_t)HALF * K * 2;
    const size_t tstep = 2 * hstep;
    const unsigned ldsw = (unsigned)wid * 1024u;
    const int aoff = lds_byte(wr * 64 + fr, fq * 8), boff = lds_byte(wc * 32 + fr, fq * 8);
#define PG8_SA(b, h) (((b) * 2 + (h)) * HTB)
#define PG8_SB(b, h) ((4 + (b) * 2 + (h)) * HTB)
#define PG8_STAGE(bufoff, gbase, voff) do { _Pragma("unroll") for (int _i = 0; _i < 2; ++_i) \
        __builtin_amdgcn_global_load_lds((const unsigned*)((const char*)(gbase) + (voff)[_i]), (LAS unsigned*)(lds + (bufoff) + ldsw + _i * 8192), 16, 0, 0); } while (0)
#define PG8_LDA(dst, b, h) do { _Pragma("unroll") for (int m = 0; m < 4; ++m) _Pragma("unroll") for (int k = 0; k < 2; ++k) dst[m][k] = *(const LAS bf16x8*)(lds + PG8_SA(b, h) + aoff + m * 2048 + k * 1024); } while (0)
#define PG8_LDB(dst, b, h) do { _Pragma("unroll") for (int n = 0; n < 2; ++n) _Pragma("unroll") for (int k = 0; k < 2; ++k) dst[n][k] = *(const LAS bf16x8*)(lds + PG8_SB(b, h) + boff + n * 2048 + k * 1024); } while (0)
#define PG8_MMA(ai, bj, At, Bt) do { __builtin_amdgcn_s_setprio(1); _Pragma("unroll") for (int m = 0; m < 4; ++m) _Pragma("unroll") for (int n = 0; n < 2; ++n) _Pragma("unroll") for (int k = 0; k < 2; ++k) \
        acc[ai][bj][m][n] = __builtin_amdgcn_mfma_f32_16x16x32_bf16(Bt[n][k], At[m][k], acc[ai][bj][m][n], 0, 0, 0); __builtin_amdgcn_s_setprio(0); } while (0)
#define PG8_WAIT_V(n) asm volatile("s_waitcnt vmcnt(" #n ")" ::: "memory")
#define PG8_WAIT_L(n) asm volatile("s_waitcnt lgkmcnt(" #n ")" ::: "memory")
#define PG8_BAR __builtin_amdgcn_s_barrier()
#define PG8_SCHED __builtin_amdgcn_sched_barrier(0)
    Unit cur, nxt; int ui = 0;
    if (!S.next(0, cur)) return;
    f32x4 acc[2][2][4][2];
#pragma unroll
    for (int a = 0; a < 2; ++a)
#pragma unroll
        for (int b = 0; b < 2; ++b)
#pragma unroll
            for (int m = 0; m < 4; ++m)
#pragma unroll
                for (int n = 0; n < 2; ++n) acc[a][b][m][n] = (f32x4){0.f, 0.f, 0.f, 0.f};
    bf16x8 At[4][2], B0[2][2], B1[2][2];
    const char* cA = (const char*)(cur.kind ? g.A1 : g.A0) + (size_t)cur.pm * tstep; const char* cB = (const char*)(cur.kind ? g.B1 : g.B0) + (size_t)cur.pn * tstep;
    if constexpr (SP2) {
        PG8_STAGE(PG8_SB(0, 0), cB, voffB); PG8_STAGE(PG8_SB(0, 1), cB + hstep, voffB); PG8_STAGE(PG8_SA(0, 0), cA, voffA); PG8_STAGE(PG8_SA(0, 1), cA + hstep, voffA);
        if (wr == 1) PG8_BAR;
        PG8_WAIT_V(2); PG8_BAR;
        PG8_STAGE(PG8_SB(1, 0), cB + kstep, voffB); PG8_STAGE(PG8_SA(1, 0), cA + kstep, voffA); PG8_STAGE(PG8_SB(1, 1), cB + hstep + kstep, voffB);
        PG8_WAIT_V(6); PG8_BAR;
    } else {
    PG8_STAGE(PG8_SB(0, 0), cB, voffB); PG8_STAGE(PG8_SA(0, 0), cA, voffA); PG8_STAGE(PG8_SB(0, 1), cB + hstep, voffB); PG8_STAGE(PG8_SA(0, 1), cA + hstep, voffA);
    if (wr == 1) PG8_BAR;
    PG8_WAIT_V(4); PG8_BAR;
    PG8_STAGE(PG8_SB(1, 0), cB + kstep, voffB); PG8_STAGE(PG8_SA(1, 0), cA + kstep, voffA); PG8_STAGE(PG8_SB(1, 1), cB + hstep + kstep, voffB);
    PG8_WAIT_V(6); PG8_BAR;
    }
    for (;;) {
        const bool has_next = S.next(ui + 1, nxt);
        const char* nA = has_next ? (const char*)(nxt.kind ? g.A1 : g.A0) + (size_t)nxt.pm * tstep : cA; const char* nB = has_next ? (const char*)(nxt.kind ? g.B1 : g.B0) + (size_t)nxt.pn * tstep : cB;
        for (int t = 0; t < nt; t += 2) {
            const bool last = (t == nt - 2);
            const char* a1 = cA + (size_t)(t + 1) * kstep;
            const char* a2 = last ? nA : cA + (size_t)(t + 2) * kstep; const char* b2 = last ? nB : cB + (size_t)(t + 2) * kstep;
            const char* a3 = a2 + kstep; const char* b3 = b2 + kstep;
            if constexpr (SP2) {
            PG8_LDB(B0, 0, 0); PG8_LDB(B1, 0, 1); PG8_SCHED; PG8_LDA(At, 0, 0); PG8_STAGE(PG8_SA(1, 1), a1 + hstep, voffA);
            PG8_WAIT_V(8); PG8_WAIT_L(0); PG8_BAR; PG8_MMA(0, 0, At, B0); PG8_MMA(0, 1, At, B1); PG8_BAR; PG8_SCHED;
            PG8_LDA(At, 0, 1); PG8_STAGE(PG8_SB(0, 0), b2, voffB); PG8_STAGE(PG8_SB(0, 1), b2 + hstep, voffB); PG8_STAGE(PG8_SA(0, 0), a2, voffA);
            PG8_WAIT_V(8); PG8_WAIT_L(0); PG8_BAR; PG8_MMA(1, 0, At, B0); PG8_MMA(1, 1, At, B1); PG8_BAR; PG8_SCHED;
            PG8_LDB(B0, 1, 0); PG8_LDB(B1, 1, 1); PG8_SCHED; PG8_LDA(At, 1, 0); PG8_STAGE(PG8_SA(0, 1), a2 + hstep, voffA);
            PG8_WAIT_V(8); PG8_WAIT_L(0); PG8_BAR; PG8_MMA(0, 0, At, B0); PG8_MMA(0, 1, At, B1); PG8_BAR; PG8_SCHED;
            PG8_LDA(At, 1, 1); PG8_STAGE(PG8_SB(1, 0), b3, voffB); PG8_STAGE(PG8_SB(1, 1), b3 + hstep, voffB); PG8_STAGE(PG8_SA(1, 0), a3, voffA);
            PG8_WAIT_V(8); PG8_WAIT_L(0); PG8_BAR; PG8_MMA(1, 0, At, B0); PG8_MMA(1, 1, At, B1); PG8_BAR; PG8_SCHED;
            } else {
            PG8_LDB(B0, 0, 0); PG8_SCHED; PG8_LDA(At, 0, 0); PG8_STAGE(PG8_SA(1, 1), a1 + hstep, voffA);
            PG8_WAIT_L(8); PG8_BAR; PG8_WAIT_L(0); PG8_MMA(0, 0, At, B0); PG8_BAR; PG8_SCHED;
            PG8_LDB(B1, 0, 1); PG8_STAGE(PG8_SB(0, 0), b2, voffB);
            PG8_BAR; PG8_WAIT_L(0); PG8_MMA(0, 1, At, B1); PG8_BAR;
            PG8_LDA(At, 0, 1); PG8_STAGE(PG8_SA(0, 0), a2, voffA);
            PG8_BAR; PG8_WAIT_L(0); PG8_MMA(1, 0, At, B0); PG8_BAR; PG8_SCHED;
            PG8_STAGE(PG8_SB(0, 1), b2 + hstep, voffB);
            PG8_WAIT_V(6); PG8_BAR; PG8_MMA(1, 1, At, B1); PG8_BAR;
            PG8_LDB(B0, 1, 0); PG8_SCHED; PG8_LDA(At, 1, 0); PG8_STAGE(PG8_SA(0, 1), a2 + hstep, voffA);
            PG8_WAIT_L(8); PG8_BAR; PG8_WAIT_L(0); PG8_MMA(0, 0, At, B0); PG8_BAR; PG8_SCHED;
            PG8_LDB(B1, 1, 1); PG8_STAGE(PG8_SB(1, 0), b3, voffB);
            PG8_BAR; PG8_WAIT_L(0); PG8_MMA(0, 1, At, B1); PG8_BAR;
            PG8_LDA(At, 1, 1); PG8_STAGE(PG8_SA(1, 0), a3, voffA);
            PG8_BAR; PG8_WAIT_L(0); PG8_MMA(1, 0, At, B0); PG8_BAR; PG8_SCHED;
            PG8_STAGE(PG8_SB(1, 1), b3 + hstep, voffB);
            PG8_WAIT_V(6); PG8_BAR; PG8_MMA(1, 1, At, B1); PG8_BAR;
            }
        }
        if constexpr (ALIGN_EPI) { if (wr == 0) PG8_BAR; }
        const bool keep = E(acc, cur, wr, wc, fr, fq);
        if (!has_next) break;
        if (!keep) {
#pragma unroll
        for (int a = 0; a < 2; ++a)
#pragma unroll
            for (int b = 0; b < 2; ++b)
#pragma unroll
                for (int m = 0; m < 4; ++m)
#pragma unroll
                    for (int n = 0; n < 2; ++n) acc[a][b][m][n] = (f32x4){0.f, 0.f, 0.f, 0.f};
        }
        cur = nxt; cA = nA; cB = nB; ++ui;
        if constexpr (ALIGN_EPI) { if (wr == 1) PG8_BAR; }
    }
    PG8_WAIT_V(0);
    if constexpr (!ALIGN_EPI) { if (wr == 0) PG8_BAR; }
    PG8_BAR;
#undef PG8_SA
#undef PG8_SB
#undef PG8_STAGE
#undef PG8_LDA
#undef PG8_LDB
#undef PG8_MMA
#undef PG8_WAIT_V
#undef PG8_WAIT_L
#undef PG8_BAR
#undef PG8_SCHED
}
}

typedef unsigned long long ssq_t;
constexpr float SSQ_SCALE = 16777216.0f;
__device__ __forceinline__ ssq_t ssq_fix(float s) { return (ssq_t)(s * SSQ_SCALE + 0.5f); }
__device__ __forceinline__ float row_rstd(const ssq_t* ss, int row) { return rsqrtf((float)ss[row] * (1.0f / SSQ_SCALE) * (1.0f / D) + EPS); }

struct EpiGU {
    static constexpr bool PERM = true;
    const ssq_t* ss; bf16_t* act;
    __device__ __forceinline__ bool operator()(f32x4 (&acc)[2][2][4][2], const pg8::Unit& u, int wr, int wc, int fr, int fq) const {
        const int row0 = u.pm * 256 + wr * 64 + fr, col0 = u.pn * 128 + wc * 32 + 8 * fq;
#pragma unroll
        for (int ai = 0; ai < 2; ++ai)
#pragma unroll
            for (int m = 0; m < 4; ++m) {
                const int row = row0 + ai * 128 + m * 16; const float r = row_rstd(ss, row);
                float o[8];
#pragma unroll
                for (int n = 0; n < 2; ++n)
#pragma unroll
                    for (int j = 0; j < 4; ++j) { const float gv = acc[ai][0][m][n][j] * r, uv = acc[ai][1][m][n][j] * r; o[n * 4 + j] = gv * sigmoidf_(gv) * uv; }
                u32x4 w; w.x = pk2(o[0], o[1]); w.y = pk2(o[2], o[3]); w.z = pk2(o[4], o[5]); w.w = pk2(o[6], o[7]);
                *(u32x4*)(act + (size_t)row * FF + col0) = w;
            }
        return false;
    }
};
struct EpiRes {
    static constexpr bool PERM = false;
    const float* xin32; bf16_t* xb; ssq_t* ss_out; float scale;
    __device__ __forceinline__ bool operator()(f32x4 (&acc)[2][2][4][2], const pg8::Unit& u, int wr, int wc, int fr, int fq) const {
        const int row0 = u.pm * 256 + wr * 64 + fr, col0 = u.pn * 256 + wc * 32 + 4 * fq;
#pragma unroll
        for (int ai = 0; ai < 2; ++ai)
#pragma unroll
            for (int m = 0; m < 4; ++m) {
                const int row = row0 + ai * 128 + m * 16; float s = 0.f;
#pragma unroll
                for (int bj = 0; bj < 2; ++bj)
#pragma unroll
                    for (int n = 0; n < 2; ++n) {
                        const size_t off = (size_t)row * D + col0 + bj * 128 + n * 16;
                        f32x4 xv;
                        if (xin32) xv = *(const f32x4*)(xin32 + off);
                        else { const u32x2 wi = *(const u32x2*)(xb + off); xv = (f32x4){bf_lo(wi.x), bf_hi(wi.x), bf_lo(wi.y), bf_hi(wi.y)}; }
                        xv = xv + acc[ai][bj][m][n] * scale;
                        u32x2 w; w.x = pk2(xv[0], xv[1]); w.y = pk2(xv[2], xv[3]); *(u32x2*)(xb + off) = w;
                        const float r0 = bf_lo(w.x), r1 = bf_hi(w.x), r2 = bf_lo(w.y), r3 = bf_hi(w.y);
                        s += (r0 * r0 + r1 * r1) + (r2 * r2 + r3 * r3);
                    }
                s += __shfl_xor(s, 16); s += __shfl_xor(s, 32);
                if (fq == 0) __hip_atomic_fetch_add(ss_out + row, ssq_fix(s), __ATOMIC_RELAXED, __HIP_MEMORY_SCOPE_AGENT);
            }
        return false;
    }
};
struct EpiP {
    static constexpr bool PERM = true;
    const ssq_t* ss; bf16_t* P;
    __device__ __forceinline__ bool operator()(f32x4 (&acc)[2][2][4][2], const pg8::Unit& u, int wr, int wc, int fr, int fq) const {
        const int row0 = u.pm * 256 + wr * 64 + fr, col0 = u.pn * 256 + wc * 32 + 8 * fq;
#pragma unroll
        for (int ai = 0; ai < 2; ++ai)
#pragma unroll
            for (int m = 0; m < 4; ++m) {
                const int row = row0 + ai * 128 + m * 16; const float r = row_rstd(ss, row);
#pragma unroll
                for (int bj = 0; bj < 2; ++bj) {
                    const f32x4 v0 = acc[ai][bj][m][0] * r, v1 = acc[ai][bj][m][1] * r;
                    u32x4 w; w.x = pk2(v0[0], v0[1]); w.y = pk2(v0[2], v0[3]); w.z = pk2(v1[0], v1[1]); w.w = pk2(v1[2], v1[3]);
                    *(u32x4*)(P + (size_t)row * INC + col0 + bj * 128) = w;
                }
            }
        return false;
    }
};
struct EpiMerge {
    static constexpr bool PERM = true;
    const bf16_t* P; bf16_t* mg;
    __device__ __forceinline__ bool operator()(f32x4 (&acc)[2][2][4][2], const pg8::Unit& u, int wr, int wc, int fr, int fq) const {
        const int row0 = u.pm * 256 + wr * 64 + fr, col0 = u.pn * 256 + wc * 32 + 8 * fq;
#pragma unroll
        for (int ai = 0; ai < 2; ++ai)
#pragma unroll
            for (int m = 0; m < 4; ++m) {
                const int row = row0 + ai * 128 + m * 16;
#pragma unroll
                for (int bj = 0; bj < 2; ++bj) {
                    const int col = col0 + bj * 128;
                    const u32x4 gb = *(const u32x4*)(P + (size_t)row * INC + PC_GB + col);
                    if (u.kind == 0) {
                        const u32x4 ga = *(const u32x4*)(P + (size_t)row * INC + PC_GA + col);
#pragma unroll
                        for (int q = 0; q < 4; ++q) {
                            const float a0 = bf_lo(ga[q]), a1 = bf_hi(ga[q]), b0 = bf_lo(gb[q]), b1 = bf_hi(gb[q]);
                            const float r0 = (1.0f + fexp(-b0)) * __builtin_amdgcn_rcpf(1.0f + fexp(-a0));
                            const float r1 = (1.0f + fexp(-b1)) * __builtin_amdgcn_rcpf(1.0f + fexp(-a1));
                            acc[ai][bj][m][q >> 1][(q & 1) * 2 + 0] *= r0; acc[ai][bj][m][q >> 1][(q & 1) * 2 + 1] *= r1;
                        }
                    } else {
                        float o[8];
#pragma unroll
                        for (int q = 0; q < 4; ++q) {
                            o[2 * q] = acc[ai][bj][m][q >> 1][(q & 1) * 2 + 0] * sigmoidf_(bf_lo(gb[q]));
                            o[2 * q + 1] = acc[ai][bj][m][q >> 1][(q & 1) * 2 + 1] * sigmoidf_(bf_hi(gb[q]));
                        }
                        u32x4 w; w.x = pk2(o[0], o[1]); w.y = pk2(o[2], o[3]); w.z = pk2(o[4], o[5]); w.w = pk2(o[6], o[7]);
                        *(u32x4*)(mg + (size_t)row * D + col) = w;
                    }
                }
            }
        return u.kind == 0;
    }
};

__device__ __forceinline__ void p0_item(const float* W, const float* gain, int K, int N, bf16_t* WT, int mode, LAS float* scr, int item, int lane) {
    const int nblk = N / 64, kb = item / nblk, nb = item % nblk, k0 = 64 * kb, n0 = 64 * nb;
    const int kr = lane >> 4, nc = (lane & 15) * 4;
    f32x4 v[16];
#pragma unroll
    for (int i = 0; i < 16; ++i) v[i] = *(const f32x4*)(W + (size_t)(k0 + 4 * i + kr) * N + n0 + nc);
    if (gain) {
#pragma unroll
        for (int i = 0; i < 16; ++i) v[i] = v[i] * gain[k0 + 4 * i + kr];
    }
#pragma unroll
    for (int i = 0; i < 16; ++i) { LAS float* s = scr + (4 * i + kr) * 65 + nc; s[0] = v[i][0]; s[1] = v[i][1]; s[2] = v[i][2]; s[3] = v[i][3]; }
    LDS_WAIT();
    const int c = lane & 7;
    const int rbase = (mode == 0) ? n0 : ((n0 >> 7) * 256 + (mode == 2 ? 128 : 0) + (n0 & 127));
#pragma unroll
    for (int j = 0; j < 8; ++j) { const int n = (lane >> 3) + 8 * j; const LAS float* s = scr + (8 * c) * 65 + n;
        u32x4 o; o.x = pk2(s[0 * 65], s[1 * 65]); o.y = pk2(s[2 * 65], s[3 * 65]); o.z = pk2(s[4 * 65], s[5 * 65]); o.w = pk2(s[6 * 65], s[7 * 65]);
        *(u32x4*)(WT + (size_t)(rbase + n) * K + k0 + 8 * c) = o; }
    LDS_WAIT();
}

constexpr int I_FF = (D / 64) * (FF / 64), I_DN = (FF / 64) * (D / 64), I_IN = (D / 64) * (INC / 64), I_AB = (RGW / 64) * (D / 64), I_OUT = (D / 64) * (D / 64);
constexpr int I_A = 2 * I_FF + I_DN + I_IN;
constexpr int I_LAYER = 4 * I_FF + 2 * I_DN + I_IN + 2 * I_AB + I_OUT;
constexpr int I_P0 = 2 * I_FF;
constexpr int I_CUT2 = I_LAYER + 2 * I_FF;
__device__ __forceinline__ void convert_items(const Params& p, LAS unsigned char* lds, int lo, int hi, int wv, int nwv) {
    const int tid = opaque_tid(), lane = tid & 63, wave = tid >> 6;
    LAS float* scr = (LAS float*)(lds + wave * 16640);
    for (int it = lo + wv; it < hi; it += nwv) {
        const int l = it >= I_LAYER ? 1 : 0; int r = it - l * I_LAYER;
        bf16_t* wl = (bf16_t*)(p.ws + (size_t)l * SZ_LAYER);
        const float* W; const float* gain = nullptr; int K, N, mode = 0; size_t off;
        if (r < I_FF) { W = p.ffn1_wg + (size_t)l * D * FF; gain = p.ffn1_norm + l * D; K = D; N = FF; mode = 1; off = OFF_WGU1; }
        else if ((r -= I_FF) < I_FF) { W = p.ffn1_wu + (size_t)l * D * FF; gain = p.ffn1_norm + l * D; K = D; N = FF; mode = 2; off = OFF_WGU1; }
        else if ((r -= I_FF) < I_DN) { W = p.ffn1_wd + (size_t)l * D * FF; K = FF; N = D; off = OFF_WD1; }
        else if ((r -= I_DN) < I_IN) { W = p.w_in + (size_t)l * D * INC; gain = p.mix_norm + l * D; K = D; N = INC; off = OFF_WIN; }
        else if ((r -= I_IN) < I_AB) { W = p.wa + (size_t)l * RGW * D; K = RGW; N = D; off = OFF_WA; }
        else if ((r -= I_AB) < I_AB) { W = p.wb + (size_t)l * RGW * D; K = RGW; N = D; off = OFF_WB; }
        else if ((r -= I_AB) < I_OUT) { W = p.wout + (size_t)l * D * D; K = D; N = D; off = OFF_WOUT; }
        else if ((r -= I_OUT) < I_FF) { W = p.ffn2_wg + (size_t)l * D * FF; gain = p.ffn2_norm + l * D; K = D; N = FF; mode = 1; off = OFF_WGU2; }
        else if ((r -= I_FF) < I_FF) { W = p.ffn2_wu + (size_t)l * D * FF; gain = p.ffn2_norm + l * D; K = D; N = FF; mode = 2; off = OFF_WGU2; }
        else { r -= I_FF; W = p.ffn2_wd + (size_t)l * D * FF; K = FF; N = D; off = OFF_WD2; }
        p0_item(W, gain, K, N, (bf16_t*)((unsigned char*)wl + off), mode, scr, r, lane);
    }
}
__device__ __forceinline__ void tail_convert(const Params& p, LAS unsigned char* lds, int nunits, int G, int c, int lo, int hi) {
    const int rem = nunits % G, wave = opaque_tid() >> 6;
    if (rem != 0 && c < rem) return;
    convert_items(p, lds, lo, hi, (c - rem) * NWAVES + wave, (G - rem) * NWAVES);
}

__device__ __forceinline__ void p0_prologue(const Params& p, LAS unsigned char* lds, int G) {
    const int tid = opaque_tid(), lane = tid & 63, wave = tid >> 6;
    const int gw = blockIdx.x * NWAVES + wave, NGW = G * NWAVES;
    convert_items(p, lds, 0, I_P0, gw, NGW);
    ssq_t* ss = (ssq_t*)(p.ws + WS_SS); bf16_t* xb = (bf16_t*)(p.ws + WS_XB);
    for (int row = gw; row < T; row += NGW) {
        const f32x4* xr = (const f32x4*)(p.x + (size_t)row * D) + lane; u32x2* o = (u32x2*)(xb + (size_t)row * D) + lane; float s = 0.f;
#pragma unroll
        for (int j = 0; j < 8; ++j) { const f32x4 v = xr[64 * j]; s += (v[0] * v[0] + v[1] * v[1]) + (v[2] * v[2] + v[3] * v[3]); u32x2 w; w.x = pk2(v[0], v[1]); w.y = pk2(v[2], v[3]); o[64 * j] = w; }
        s = wave_sum(s); if (lane == 0) ss[row] = ssq_fix(s);
    }
    for (int i = blockIdx.x * NTHREADS + tid; i < 7 * T; i += G * NTHREADS) ss[T + i] = 0ull;
}

constexpr int H_QS = 272, H_TS = 144;
constexpr int HB_SZ = 62464, HB_QI = 0, HB_KI = 17408, HB_KIT = 34816, HB_VT = 53248;
constexpr int H_ST = 2 * HB_SZ, H_PM = H_ST + 17408, H_GT = H_PM + 9216;
static_assert(H_GT + 2 * 2048 <= LDS_BAR_OFF, "HGRN LDS image");
__device__ __forceinline__ void hgrn_chain(const Params& p, LAS unsigned char* lds, int layer, int chain, int dvh) {
    const int tid = opaque_tid(), lane = tid & 63, wave = __builtin_amdgcn_readfirstlane(tid >> 6), fr = lane & 15, fq = lane >> 4;
    const bf16_t* P = (const bf16_t*)(p.ws + WS_P);
    const int b = chain >> 4, h = (chain >> 1) & 7, dir = chain & 1;
    float* O = (float*)(p.ws + (dir ? WS_OB : WS_OF));
    const float* lbl = dir ? p.lbb : p.lbf;
    const int zc = (dir ? PC_ZB : PC_ZF) + h * 128;
    const int d = tid & 127, tg = wave >> 1;
    const int vs = tid & 63, vg = tid >> 6;
    float lb = 0.f;
    if (layer == 1) { const int ch = h * 128 + d; lb = sigmoidf_(lbl[RGW + ch] - lbl[ch]); }
    f32x4 Sacc[4];
#pragma unroll
    for (int i = 0; i < 4; ++i) Sacc[i] = (f32x4){0.f, 0.f, 0.f, 0.f};
    bf16_t zr[16], qr[16]; u32x4 vr0;
    float pb[16], kk_[16], qf[16]; u32x4 v0;
    const ptrdiff_t tstep_ = dir ? -(ptrdiff_t)INC : (ptrdiff_t)INC;
#define HG_TOK(c, j) ((size_t)b * SEQ + (dir ? ((SEQ / 64 - 1 - (c)) * 64 + 63 - (j)) : ((c) * 64 + (j))))
#define HG_LOAD(c) do { const bf16_t* zp_ = P + HG_TOK(c, tg * 16) * INC + zc + d; const bf16_t* qp_ = P + HG_TOK(c, tg * 16) * INC + PC_Q + h * 128 + d; \
        _Pragma("unroll") for (int i = 0; i < 16; ++i) { zr[i] = *zp_; qr[i] = *qp_; zp_ += tstep_; qp_ += tstep_; } \
        { const size_t tk = HG_TOK(c, vs); const bf16_t* vp = P + tk * INC + PC_I + h * 128 + dvh * 64 + vg * 8; vr0 = *(const u32x4*)vp; } } while (0)
#define HG_A1(g) do { LAS float* GT_ = (LAS float*)(lds + H_GT + (g) * 2048); float run = 1.f; \
        _Pragma("unroll") for (int i = 0; i < 16; ++i) { \
            const float e = fexp(-bf1(zr[i])), sg = __builtin_amdgcn_rcpf(1.0f + e);     \
            const float f = lb + (1.0f - lb) * sg; kk_[i] = 1.0f - f; run *= f; pb[i] = run; qf[i] = bf1(qr[i]); } \
        GT_[tg * 128 + d] = run; v0 = vr0; } while (0)
#define HG_A2(g, lb_) do { const LAS float* GT_ = (const LAS float*)(lds + H_GT + (g) * 2048); \
        const float g0 = GT_[d], g1 = GT_[128 + d], g2 = GT_[256 + d]; \
        const float den = (tg == 0) ? g0 * g1 : g1; \
        const float C = (tg >= 2) ? (tg == 3 ? g2 : 1.0f) : __builtin_amdgcn_rcpf(fmaxf(den, 1e-36f)); \
        unsigned kw[8]; \
        _Pragma("unroll") for (int i = 0; i < 16; i += 2) { \
            const float eq0 = fminf(fmaxf(pb[i] * C, 2.4e-35f), 4.15e34f), eq1 = fminf(fmaxf(pb[i + 1] * C, 2.4e-35f), 4.15e34f); \
            const float ek0 = __builtin_amdgcn_rcpf(eq0), ek1 = __builtin_amdgcn_rcpf(eq1); \
            const unsigned qw = pk2(qf[i] * eq0, qf[i + 1] * eq1); kw[i >> 1] = pk2(kk_[i] * ek0, kk_[i + 1] * ek1); \
            const int j = tg * 16 + i; \
            *(LAS bf16_t*)((lb_) + HB_QI + j * H_QS + d * 2) = (bf16_t)(qw & 0xffffu); *(LAS bf16_t*)((lb_) + HB_QI + (j + 1) * H_QS + d * 2) = (bf16_t)(qw >> 16); \
            *(LAS bf16_t*)((lb_) + HB_KI + j * H_QS + d * 2) = (bf16_t)(kw[i >> 1] & 0xffffu); *(LAS bf16_t*)((lb_) + HB_KI + (j + 1) * H_QS + d * 2) = (bf16_t)(kw[i >> 1] >> 16); } \
        u32x4 w0, w1; w0.x = kw[0]; w0.y = kw[1]; w0.z = kw[2]; w0.w = kw[3]; w1.x = kw[4]; w1.y = kw[5]; w1.z = kw[6]; w1.w = kw[7]; \
        *(LAS u32x4*)((lb_) + HB_KIT + d * H_TS + tg * 32) = w0; *(LAS u32x4*)((lb_) + HB_KIT + d * H_TS + tg * 32 + 16) = w1; \
        _Pragma("unroll") for (int q = 0; q < 4; ++q) { \
            *(LAS bf16_t*)((lb_) + HB_VT + (vg * 8 + 2 * q) * H_TS + vs * 2) = (bf16_t)(v0[q] & 0xffffu); *(LAS bf16_t*)((lb_) + HB_VT + (vg * 8 + 2 * q + 1) * H_TS + vs * 2) = (bf16_t)(v0[q] >> 16); } } while (0)
    HG_LOAD(0);
    HG_A1(0);
    HG_LOAD(1);
    LDS_BARRIER();
    HG_A2(0, lds);
    LDS_BARRIER();
    for (int c = 0; c < SEQ / 64; ++c) {
        const int cur = c & 1;
        LAS unsigned char* lc = lds + cur * HB_SZ;
        LAS unsigned char* ln = lds + (cur ^ 1) * HB_SZ;
#pragma unroll
        for (int dvt = 0; dvt < 4; ++dvt) {
            u32x2 w; w.x = pk2(Sacc[dvt][0], Sacc[dvt][1]); w.y = pk2(Sacc[dvt][2], Sacc[dvt][3]);
            *(LAS u32x2*)(lds + H_ST + (dvt * 16 + fr) * H_QS + (wave * 16 + fq * 4) * 2) = w;
        }
        {
            const int tt = wave >> 1;
#pragma unroll
            for (int u = 0; u < 2; ++u) {
                const int st = (wave & 1) * 2 + u;
                f32x4 a4 = (f32x4){0.f, 0.f, 0.f, 0.f};
                if (st <= tt) {
#pragma unroll
                    for (int kk = 0; kk < 4; ++kk) {
                        const bf16x8 ka = *(const LAS bf16x8*)(lc + HB_KI + (st * 16 + fr) * H_QS + (kk * 32 + fq * 8) * 2);
                        const bf16x8 qb = *(const LAS bf16x8*)(lc + HB_QI + (tt * 16 + fr) * H_QS + (kk * 32 + fq * 8) * 2);
                        a4 = __builtin_amdgcn_mfma_f32_16x16x32_bf16(ka, qb, a4, 0, 0, 0);
                    }
                    const int t = tt * 16 + fr;
#pragma unroll
                    for (int j = 0; j < 4; ++j) { const int s = st * 16 + fq * 4 + j; a4[j] = (st < tt || s <= t) ? a4[j] : 0.f; }
                }
                u32x2 w; w.x = pk2(a4[0], a4[1]); w.y = pk2(a4[2], a4[3]);
                *(LAS u32x2*)(lds + H_PM + (tt * 16 + fr) * H_TS + (st * 16 + fq * 4) * 2) = w;
            }
        }
        if (c + 1 < SEQ / 64) { HG_A1(cur ^ 1); if (c + 2 < SEQ / 64) HG_LOAD(c + 2); }
        LDS_BARRIER();
        {
            const int dvt = wave & 3;
            bf16x8 va[2], sa[4];
#pragma unroll
            for (int ks = 0; ks < 2; ++ks) va[ks] = *(const LAS bf16x8*)(lc + HB_VT + (dvt * 16 + fr) * H_TS + (ks * 32 + fq * 8) * 2);
#pragma unroll
            for (int kk = 0; kk < 4; ++kk) sa[kk] = *(const LAS bf16x8*)(lds + H_ST + (dvt * 16 + fr) * H_QS + (kk * 32 + fq * 8) * 2);
#pragma unroll
            for (int u = 0; u < 2; ++u) {
                const int tt = (wave >> 2) * 2 + u;
                f32x4 o4 = (f32x4){0.f, 0.f, 0.f, 0.f};
#pragma unroll
                for (int ks = 0; ks < 2; ++ks) { const bf16x8 pbf = *(const LAS bf16x8*)(lds + H_PM + (tt * 16 + fr) * H_TS + (ks * 32 + fq * 8) * 2); o4 = __builtin_amdgcn_mfma_f32_16x16x32_bf16(va[ks], pbf, o4, 0, 0, 0); }
#pragma unroll
                for (int kk = 0; kk < 4; ++kk) { const bf16x8 qb = *(const LAS bf16x8*)(lc + HB_QI + (tt * 16 + fr) * H_QS + (kk * 32 + fq * 8) * 2); o4 = __builtin_amdgcn_mfma_f32_16x16x32_bf16(sa[kk], qb, o4, 0, 0, 0); }
                *(f32x4*)(O + HG_TOK(c, tt * 16 + fr) * RGW + h * 128 + dvh * 64 + dvt * 16 + fq * 4) = o4;
            }
        }
        {
            f32x4 sc;
            {
                const LAS float* GT = (const LAS float*)(lds + H_GT + cur * 2048) + wave * 16 + fq * 4;
                sc = *(const LAS f32x4*)(GT + 256) * *(const LAS f32x4*)(GT + 384);
                if (c + 1 < SEQ / 64) { const LAS float* GN = (const LAS float*)(lds + H_GT + (cur ^ 1) * 2048) + wave * 16 + fq * 4; sc = sc * (*(const LAS f32x4*)GN * *(const LAS f32x4*)(GN + 128)); }
            }
            bf16x8 ka[2];
#pragma unroll
            for (int ks = 0; ks < 2; ++ks) ka[ks] = *(const LAS bf16x8*)(lc + HB_KIT + (wave * 16 + fr) * H_TS + (ks * 32 + fq * 8) * 2);
#pragma unroll
            for (int dvt = 0; dvt < 4; ++dvt) {
#pragma unroll
                for (int ks = 0; ks < 2; ++ks) { const bf16x8 vb = *(const LAS bf16x8*)(lc + HB_VT + (dvt * 16 + fr) * H_TS + (ks * 32 + fq * 8) * 2); Sacc[dvt] = __builtin_amdgcn_mfma_f32_16x16x32_bf16(ka[ks], vb, Sacc[dvt], 0, 0, 0); }
                Sacc[dvt] = Sacc[dvt] * sc;
            }
        }
        if (c + 1 < SEQ / 64) HG_A2(cur ^ 1, ln);
        LDS_BARRIER();
    }
    __syncthreads();
#undef HG_A1
#undef HG_A2
#undef HG_LOAD
#undef HG_TOK
}

__device__ __forceinline__ void post_phase(const Params& p, int G, int layer) {
    const int tid = opaque_tid(), lane = tid & 63, wave = tid >> 6;
    const bf16_t* P = (const bf16_t*)(p.ws + WS_P); const float* OF = (const float*)(p.ws + WS_OF); const float* OB = (const float*)(p.ws + WS_OB);
    bf16_t* OA = (bf16_t*)(p.ws + WS_OA); const float* gain = p.rg_norm + layer * RGW;
    for (int pr = blockIdx.x * NWAVES + wave; pr < T * 8; pr += G * NWAVES) {
        const int tok = pr >> 3, h = pr & 7; const size_t off = (size_t)tok * RGW + h * 128 + 2 * lane;
        const f32x2 a = *(const f32x2*)(OF + off), bq = *(const f32x2*)(OB + off);
        const float o0 = a[0] + bq[0], o1 = a[1] + bq[1];
        const float s = wave_sum(o0 * o0 + o1 * o1); const float r = rsqrtf(s * (1.0f / 128.0f) + EPS);
        const unsigned gw_ = *(const unsigned*)(P + (size_t)tok * INC + PC_G + h * 128 + 2 * lane);
        const float g0 = bf_lo(gw_), g1 = bf_hi(gw_);
        const f32x2 gn = *(const f32x2*)(gain + h * 128 + 2 * lane);
        *(unsigned*)(OA + off) = pk2(o0 * r * gn[0] * (g0 * sigmoidf_(g0)), o1 * r * gn[1] * (g1 * sigmoidf_(g1)));
    }
}

constexpr int KST = 272;
constexpr int VST = 136;
__device__ __forceinline__ void attn_phase(const Params& p, LAS unsigned char* lds, int first, int stride, int layer) {
    const int tid = opaque_tid(), lane = tid & 63, wave = tid >> 6, fr = lane & 15, fq = lane >> 4;
    const bf16_t* P = (const bf16_t*)(p.ws + WS_P); bf16_t* OT = (bf16_t*)(p.ws + WS_OT);
    LAS unsigned char* Kt = lds;
    LAS unsigned char* Vt = lds + 64 * KST;
    for (int item = first; item < 4 * 16 * 8; item += stride) {
        const int h = item & 7, qb = (item >> 3) & 15, b = item >> 7, kvh = h >> 2;
        const float slope = exp2f(-(float)(h + 1)), sinkv = p.sink[layer * 8 + h];
        const int q0 = qb * 128, qw = q0 + wave * 16, qt = qw + fr;
        const size_t tokq = (size_t)b * SEQ + qt;
        bf16x8 Qf[4];
#pragma unroll
        for (int kk = 0; kk < 4; ++kk) Qf[kk] = *(const bf16x8*)(P + tokq * INC + PC_AQ + h * 128 + kk * 32 + fq * 8);
        f32x4 Oa[8];
#pragma unroll
        for (int i = 0; i < 8; ++i) Oa[i] = (f32x4){0.f, 0.f, 0.f, 0.f};
        float mrun = sinkv, lrun = 1.0f;
        const int kb_lo = (q0 - 128 < 0) ? 2 : 0, kb_hi = (q0 + 256 > SEQ) ? 4 : 6;
        const int skey = tid >> 4, sd0 = (tid & 15) * 8;
        u32x4 kreg[2], vreg[2];
#define AT_LOAD(kb_) do { const int k0_ = q0 - 128 + (kb_) * 64; _Pragma("unroll") for (int i = 0; i < 2; ++i) { const size_t tk = (size_t)b * SEQ + k0_ + skey + i * 32; \
            kreg[i] = *(const u32x4*)(P + tk * INC + PC_AK + kvh * 128 + sd0); vreg[i] = *(const u32x4*)(P + tk * INC + PC_AV + kvh * 128 + sd0); } } while (0)
        AT_LOAD(kb_lo);
        for (int kb = kb_lo; kb < kb_hi; ++kb) {
            const int k0 = q0 - 128 + kb * 64;
            __syncthreads();
#pragma unroll
            for (int i = 0; i < 2; ++i) {
                const int key = skey + i * 32;
                *(LAS u32x4*)(Kt + key * KST + sd0 * 2) = kreg[i];
#pragma unroll
                for (int q = 0; q < 4; ++q) {
                    *(LAS bf16_t*)(Vt + (sd0 + 2 * q) * VST + key * 2) = (bf16_t)(vreg[i][q] & 0xffffu);
                    *(LAS bf16_t*)(Vt + (sd0 + 2 * q + 1) * VST + key * 2) = (bf16_t)(vreg[i][q] >> 16);
                }
            }
            __syncthreads();
            if (kb + 1 < kb_hi) AT_LOAD(kb + 1);
            if (k0 + 63 < qw - 128 || k0 > qw + 15 + 128) continue;
            f32x4 Sa[4];
#pragma unroll
            for (int t = 0; t < 4; ++t) {
                Sa[t] = (f32x4){0.f, 0.f, 0.f, 0.f};
#pragma unroll
                for (int kk = 0; kk < 4; ++kk) {
                    const bf16x8 kf = *(const LAS bf16x8*)(Kt + (t * 16 + fr) * KST + (kk * 32 + fq * 8) * 2);
                    Sa[t] = __builtin_amdgcn_mfma_f32_16x16x32_bf16(kf, Qf[kk], Sa[t], 0, 0, 0);
                }
            }
            float mloc = -INFINITY;
#pragma unroll
            for (int t = 0; t < 4; ++t)
#pragma unroll
                for (int j = 0; j < 4; ++j) {
                    const int kt = k0 + t * 16 + fq * 4 + j; const int rel = kt - qt; const int ar = rel < 0 ? -rel : rel;
                    float s = Sa[t][j] * 0.08838834764831845f - slope * (float)ar;
                    s = (ar <= 128) ? s : -INFINITY;
                    Sa[t][j] = s; mloc = fmaxf(mloc, s);
                }
            mloc = fmaxf(mloc, __shfl_xor(mloc, 16)); mloc = fmaxf(mloc, __shfl_xor(mloc, 32));
            const float mnew = fmaxf(mrun, mloc), alpha = fexp(mrun - mnew);
            float lsum = 0.f;
#pragma unroll
            for (int t = 0; t < 4; ++t)
#pragma unroll
                for (int j = 0; j < 4; ++j) { const float e = fexp(Sa[t][j] - mnew); Sa[t][j] = e; lsum += e; }
            lsum += __shfl_xor(lsum, 16); lsum += __shfl_xor(lsum, 32);
            lrun = lrun * alpha + lsum; mrun = mnew;
#pragma unroll
            for (int i = 0; i < 8; ++i) Oa[i] = Oa[i] * alpha;
            bf16x8 Pf[2];
#pragma unroll
            for (int s2 = 0; s2 < 2; ++s2) {
                u32x4 w; w.x = pk2(Sa[2 * s2][0], Sa[2 * s2][1]); w.y = pk2(Sa[2 * s2][2], Sa[2 * s2][3]); w.z = pk2(Sa[2 * s2 + 1][0], Sa[2 * s2 + 1][1]); w.w = pk2(Sa[2 * s2 + 1][2], Sa[2 * s2 + 1][3]);
                Pf[s2] = __builtin_bit_cast(bf16x8, w);
            }
#pragma unroll
            for (int dt = 0; dt < 8; ++dt)
#pragma unroll
                for (int s2 = 0; s2 < 2; ++s2) {
                    const LAS unsigned char* vp = Vt + (dt * 16 + fr) * VST + (s2 * 32 + fq * 4) * 2;
                    const u32x2 lo = *(const LAS u32x2*)vp, hi = *(const LAS u32x2*)(vp + 32);
                    u32x4 w; w.x = lo.x; w.y = lo.y; w.z = hi.x; w.w = hi.y;
                    Oa[dt] = __builtin_amdgcn_mfma_f32_16x16x32_bf16(__builtin_bit_cast(bf16x8, w), Pf[s2], Oa[dt], 0, 0, 0);
                }
        }
        const float inv = 1.0f / lrun;
#pragma unroll
        for (int dt = 0; dt < 8; ++dt) {
            u32x2 w; w.x = pk2(Oa[dt][0] * inv, Oa[dt][1] * inv); w.y = pk2(Oa[dt][2] * inv, Oa[dt][3] * inv);
            *(u32x2*)(OT + tokq * RGW + h * 128 + dt * 16 + fq * 4) = w;
        }
    }
}

__device__ __forceinline__ void final_phase(const Params& p, int G) {
    const int tid = opaque_tid(), lane = tid & 63, wave = tid >> 6;
    const bf16_t* XBp = (const bf16_t*)(p.ws + WS_XB); const ssq_t* ss = (const ssq_t*)(p.ws + WS_SS) + 6 * T;
    for (int row = blockIdx.x * NWAVES + wave; row < T; row += G * NWAVES) {
        const float r = row_rstd(ss, row);
        const u32x2* xr = (const u32x2*)(XBp + (size_t)row * D) + lane; const f32x4* gr = (const f32x4*)p.final_norm + lane; f32x4* o = (f32x4*)(p.out + (size_t)row * D) + lane;
#pragma unroll
        for (int j = 0; j < 8; ++j) { const u32x2 w = xr[64 * j]; const f32x4 xv = (f32x4){bf_lo(w.x), bf_hi(w.x), bf_lo(w.y), bf_hi(w.y)}; o[64 * j] = xv * r * gr[64 * j]; }
    }
}

__global__ void __launch_bounds__(NTHREADS, 2) fwd_megakernel(Params p) {
    extern __shared__ __attribute__((aligned(16))) unsigned char lds_raw[];
    LAS unsigned char* lds = (LAS unsigned char*)lds_raw;
    cg::grid_group grid = cg::this_grid();
    if (threadIdx.x < 4) ((LAS unsigned*)(lds + LDS_BAR_OFF))[threadIdx.x] = 0u;
    __syncthreads();
    XcdBarrier xbar = xcd_barrier_post((unsigned*)(p.ws + WS_BAR), (volatile LAS unsigned*)(lds + LDS_BAR_OFF));
    if (p.ws == nullptr) grid.sync();
#define GSYNC() xcd_barrier(xbar)
    const int G = gridDim.x, c = blockIdx.x;
    unsigned char* ws = p.ws;
    float* X = (float*)(ws + WS_X); bf16_t* XB = (bf16_t*)(ws + WS_XB); ssq_t* SS = (ssq_t*)(ws + WS_SS);
    bf16_t* ACT = (bf16_t*)(ws + WS_ACT); bf16_t* Pb = (bf16_t*)(ws + WS_P);
    bf16_t* OA = (bf16_t*)(ws + WS_OA); bf16_t* OT = (bf16_t*)(ws + WS_OT); bf16_t* MG = (bf16_t*)(ws + WS_MG);

#ifndef PHMASK
#define PHMASK 0xffff
#endif
#define PH(n) ((PHMASK >> (n)) & 1)
#if PH(0)
    p0_prologue(p, lds, G);
#endif
    GSYNC();
#pragma unroll 1
    for (int l = 0; l < 2; ++l) {
        const unsigned char* wl = ws + (size_t)l * SZ_LAYER;
        const ssq_t* ss_ffn1 = SS + (3 * l + 0) * T; ssq_t* ss_mix = SS + (3 * l + 1) * T; ssq_t* ss_ffn2 = SS + (3 * l + 2) * T; ssq_t* ss_next = SS + (3 * l + 3) * T;
#if PH(1)
        { pg8::Gemm g{XB, (const bf16_t*)(wl + OFF_WGU1), XB, (const bf16_t*)(wl + OFF_WGU1), T, 2 * FF, D}; pg8::StaticOrder S; S.init(T, 2 * FF, G, c);
          EpiGU E{ss_ffn1, ACT}; pg8::gemm_phase(lds, g, S, E); }
        if (l == 0) tail_convert(p, lds, (T / 256) * (2 * FF / 256), G, c, I_P0, I_A);
#endif
        GSYNC();
#if PH(2)
        { pg8::Gemm g{ACT, (const bf16_t*)(wl + OFF_WD1), ACT, (const bf16_t*)(wl + OFF_WD1), T, D, FF}; pg8::StaticOrder S; S.init(T, D, G, c);
          EpiRes E{l == 0 ? p.x : nullptr, XB, ss_mix, 0.5f}; pg8::gemm_phase(lds, g, S, E); }
#endif
        GSYNC();
#if PH(3)
        { pg8::Gemm g{XB, (const bf16_t*)(wl + OFF_WIN), XB, (const bf16_t*)(wl + OFF_WIN), T, INC, D}; pg8::StaticOrder S; S.init(T, INC, G, c);
          EpiP E{ss_mix, Pb}; pg8::gemm_phase(lds, g, S, E); }
        tail_convert(p, lds, (T / 256) * (INC / 256), G, c, l * I_LAYER + I_A, (l + 1) * I_LAYER);
#endif
        GSYNC();
#if PH(4)
        { const int hw = (G >= 256) ? 128 : 0;
          if (hw == 0 || c < hw) for (int ch = c; ch < 128; ch += (hw ? 128 : G)) hgrn_chain(p, lds, l, ch >> 1, ch & 1);
          if (c >= hw) { attn_phase(p, lds, c - hw, G - hw, l); __syncthreads(); if (l == 0) convert_items(p, lds, I_LAYER, I_CUT2, (c - hw) * NWAVES + (opaque_tid() >> 6), (G - hw) * NWAVES); } }
#endif
        GSYNC();
#if PH(6)
        post_phase(p, G, l);
#endif
        GSYNC();
#if PH(7)
        { pg8::Gemm g{OA, (const bf16_t*)(wl + OFF_WA), OT, (const bf16_t*)(wl + OFF_WB), T, D, RGW}; pg8::PairOrder S; S.init(T, D, G, c);
          EpiMerge E{Pb, MG}; pg8::gemm_phase(lds, g, S, E); }
#endif
        GSYNC();
#if PH(8)
        { pg8::Gemm g{MG, (const bf16_t*)(wl + OFF_WOUT), MG, (const bf16_t*)(wl + OFF_WOUT), T, D, D}; pg8::StaticOrder S; S.init(T, D, G, c);
          EpiRes E{nullptr, XB, ss_ffn2, 1.0f}; pg8::gemm_phase(lds, g, S, E); }
#endif
        GSYNC();
#if PH(9)
        { pg8::Gemm g{XB, (const bf16_t*)(wl + OFF_WGU2), XB, (const bf16_t*)(wl + OFF_WGU2), T, 2 * FF, D}; pg8::StaticOrder S; S.init(T, 2 * FF, G, c);
          EpiGU E{ss_ffn2, ACT}; pg8::gemm_phase(lds, g, S, E); }
        if (l == 0) tail_convert(p, lds, (T / 256) * (2 * FF / 256), G, c, I_CUT2, I_LAYER + I_A);
#endif
        GSYNC();
#if PH(10)
        { pg8::Gemm g{ACT, (const bf16_t*)(wl + OFF_WD2), ACT, (const bf16_t*)(wl + OFF_WD2), T, D, FF}; pg8::StaticOrder S; S.init(T, D, G, c);
          EpiRes E{nullptr, XB, ss_next, 0.5f}; pg8::gemm_phase(lds, g, S, E); }
#endif
        GSYNC();
    }
#if PH(11)
    final_phase(p, G);
#endif
}

extern "C" void kernel_launch(void* const* d_in, const int* in_sizes, int n_in, void* d_out, int out_size, void* d_ws, size_t ws_size, hipStream_t stream) {
    static int grid_blocks = 0;
    if (grid_blocks == 0) {
        if (n_in != 19 || ws_size < WS_END) { fprintf(stderr, "kernel_launch: unexpected n_in %d / ws_size %zu (need %zu)\n", n_in, ws_size, (size_t)WS_END); grid_blocks = -1; return; }
        int dev = 0, cus = 0, per_cu = 0;
        hipGetDevice(&dev);
        hipDeviceGetAttribute(&cus, hipDeviceAttributeMultiprocessorCount, dev);
        hipFuncSetAttribute((const void*)fwd_megakernel, hipFuncAttributeMaxDynamicSharedMemorySize, LDS_BYTES);
        hipOccupancyMaxActiveBlocksPerMultiprocessor(&per_cu, (const void*)fwd_megakernel, NTHREADS, LDS_BYTES);
        if (per_cu < 1) { fprintf(stderr, "kernel_launch: occupancy query says %d blocks/CU\n", per_cu); per_cu = 1; }
        grid_blocks = cus * 1;
    }
    if (grid_blocks < 0) return;
    Params p{};
    p.x = (const float*)d_in[0]; p.ffn1_norm = (const float*)d_in[1]; p.ffn1_wg = (const float*)d_in[2]; p.ffn1_wu = (const float*)d_in[3]; p.ffn1_wd = (const float*)d_in[4];
    p.mix_norm = (const float*)d_in[5]; p.w_in = (const float*)d_in[6]; p.lbf = (const float*)d_in[7]; p.lbb = (const float*)d_in[8]; p.rg_norm = (const float*)d_in[9];
    p.sink = (const float*)d_in[10]; p.wa = (const float*)d_in[11]; p.wb = (const float*)d_in[12]; p.wout = (const float*)d_in[13];
    p.ffn2_norm = (const float*)d_in[14]; p.ffn2_wg = (const float*)d_in[15]; p.ffn2_wu = (const float*)d_in[16]; p.ffn2_wd = (const float*)d_in[17]; p.final_norm = (const float*)d_in[18];
    p.out = (float*)d_out; p.ws = (unsigned char*)d_ws;
    if (hipMemsetAsync((char*)d_ws + WS_BAR, 0, 16384, stream) != hipSuccess) { fprintf(stderr, "kernel_launch: memset failed\n"); return; }
    void* args[] = {&p};
    hipError_t e = hipLaunchCooperativeKernel((const void*)fwd_megakernel, dim3(grid_blocks), dim3(NTHREADS), args, LDS_BYTES, stream);
    if (e != hipSuccess) fprintf(stderr, "cooperative launch failed: %s (grid %d)\n", hipGetErrorString(e), grid_blocks);
}
```

```cpp
#include <hip/hip_runtime.h>
#include <hip/hip_cooperative_groups.h>
#include <cstdio>
namespace cg = cooperative_groups;

#define LAS __attribute__((address_space(3)))
typedef unsigned short bf16_t;
typedef short bf16x8 __attribute__((ext_vector_type(8)));
typedef short bf16x4 __attribute__((ext_vector_type(4)));
typedef float f32x4 __attribute__((ext_vector_type(4)));
typedef float f32x2 __attribute__((ext_vector_type(2)));
typedef unsigned u32x4 __attribute__((ext_vector_type(4)));
typedef unsigned u32x2 __attribute__((ext_vector_type(2)));

constexpr int T = 8192, D = 2048, FF = 5632, INC = 10752, SEQ = 2048, RGW = 1024;
constexpr float EPS = 1e-6f;
constexpr int NTHREADS = 512, NWAVES = 8;
constexpr int LDS_BAR_OFF = 155648;
constexpr int LDS_BYTES = LDS_BAR_OFF + 16;

constexpr int PC_Q = 0, PC_I = 1024, PC_ZF = 2048, PC_ZB = 3072, PC_G = 4096, PC_AQ = 5120, PC_AK = 6144, PC_AV = 6400, PC_GA = 6656, PC_GB = 8704;

constexpr size_t SZ_WGU = (size_t)2 * FF * D * 2, SZ_WD = (size_t)D * FF * 2, SZ_WIN = (size_t)INC * D * 2, SZ_WAB = (size_t)D * RGW * 2, SZ_WOUT = (size_t)D * D * 2;
constexpr size_t OFF_WGU1 = 0, OFF_WD1 = OFF_WGU1 + SZ_WGU, OFF_WIN = OFF_WD1 + SZ_WD, OFF_WA = OFF_WIN + SZ_WIN, OFF_WB = OFF_WA + SZ_WAB, OFF_WOUT = OFF_WB + SZ_WAB,
                 OFF_WGU2 = OFF_WOUT + SZ_WOUT, OFF_WD2 = OFF_WGU2 + SZ_WGU, SZ_LAYER = OFF_WD2 + SZ_WD;
constexpr size_t WS_X = 2 * SZ_LAYER, WS_XB = WS_X + (size_t)T * D * 4, WS_SS = WS_XB + (size_t)T * D * 2, WS_BAR = WS_SS + (size_t)8 * T * 8, WS_REG = WS_BAR + 16384;
constexpr size_t WS_ACT = WS_REG;
constexpr size_t WS_P = WS_REG;
constexpr size_t WS_OF = WS_P + (size_t)T * INC * 2;
constexpr size_t WS_OB = WS_OF + (size_t)T * RGW * 4;
constexpr size_t WS_OA = WS_OB + (size_t)T * RGW * 4;
constexpr size_t WS_OT = WS_OA + (size_t)T * RGW * 2;
constexpr size_t WS_MG = WS_OT + (size_t)T * RGW * 2;
constexpr size_t WS_END = WS_MG + (size_t)T * D * 2;

struct Params {
    const float* x; const float* ffn1_norm; const float* ffn1_wg; const float* ffn1_wu; const float* ffn1_wd; const float* mix_norm; const float* w_in;
    const float* lbf; const float* lbb; const float* rg_norm; const float* sink; const float* wa; const float* wb; const float* wout;
    const float* ffn2_norm; const float* ffn2_wg; const float* ffn2_wu; const float* ffn2_wd; const float* final_norm;
    float* out; unsigned char* ws;
};

__device__ __forceinline__ unsigned pk2(float lo, float hi) { unsigned r; asm("v_cvt_pk_bf16_f32 %0, %1, %2" : "=v"(r) : "v"(lo), "v"(hi)); return r; }
__device__ __forceinline__ float bf_lo(unsigned w) { return __uint_as_float(w << 16); }
__device__ __forceinline__ float bf_hi(unsigned w) { return __uint_as_float(w & 0xffff0000u); }
__device__ __forceinline__ float bf1(bf16_t w) { return __uint_as_float(((unsigned)w) << 16); }
__device__ __forceinline__ float wave_sum(float v) {
#pragma unroll
    for (int o = 1; o < 64; o <<= 1) v += __shfl_xor(v, o);
    return v;
}
__device__ __forceinline__ float fexp(float v) { return __builtin_amdgcn_exp2f(v * 1.4426950408889634f); }
__device__ __forceinline__ float flog(float v) { return __builtin_amdgcn_logf(v) * 0.6931471805599453f; }
__device__ __forceinline__ float sigmoidf_(float v) { return __builtin_amdgcn_rcpf(1.0f + fexp(-v)); }
#define LDS_WAIT() asm volatile("s_waitcnt lgkmcnt(0)" ::: "memory")
#define LDS_BARRIER() do { asm volatile("s_waitcnt lgkmcnt(0)" ::: "memory"); __builtin_amdgcn_s_barrier(); asm volatile("" ::: "memory"); } while (0)
__device__ __forceinline__ int opaque_tid() { int t = threadIdx.x; asm volatile("" : "+v"(t)); return t; }


#define XB_TMO      128
#define XB_XCNT(j)  (256  + 64 * (j))
#define XB_XSUB(j)  (1280 + 64 * (j))
#define XB_XGEN(j)  (2304 + 64 * (j))
#define XB_TOP      3328
#define XB_TOPGEN   3392
#define XCD_BAR_WORDS 3456
#define XB_SPIN_CAP (1u << 22)
__device__ __forceinline__ unsigned xb_ld(unsigned* p)              { return __hip_atomic_load(p, __ATOMIC_RELAXED, __HIP_MEMORY_SCOPE_AGENT); }
__device__ __forceinline__ unsigned xb_add(unsigned* p, unsigned v) { return __hip_atomic_fetch_add(p, v, __ATOMIC_RELAXED, __HIP_MEMORY_SCOPE_AGENT); }
__device__ __forceinline__ unsigned xb_xcc_id() { return (unsigned)__builtin_amdgcn_s_getreg((3 << 11) | 20) & 0xFu; }
#define XB_SPIN(cond, bar) do { unsigned _sp = 0; while (cond) { __builtin_amdgcn_s_sleep(1); \
    if ((++_sp & 255u) == 0u) { if (xb_ld(&(bar)[XB_TMO])) break; if (_sp > XB_SPIN_CAP) { atomicAdd(&(bar)[XB_TMO], 1u); break; } } } } while (0)
struct XcdBarrier { unsigned* bar; unsigned x; volatile LAS unsigned* st; };
__device__ __forceinline__ XcdBarrier xcd_barrier_post(unsigned* bar, volatile LAS unsigned* st) {
    XcdBarrier b; b.bar = bar; b.x = xb_xcc_id(); b.st = st;
    if (threadIdx.x == 0) (void)xb_add(&bar[XB_XCNT(b.x)], 1u);
    return b;
}
__device__ __forceinline__ void xcd_barrier_complete(unsigned* bar, unsigned x, unsigned& nloc, unsigned& nx) {
    const unsigned G = gridDim.x * gridDim.y * gridDim.z;
    unsigned sum, cnt, mine, sp = 0u;
    for (;;) {
        sum = 0u; cnt = 0u; mine = 0u;
#pragma unroll
        for (unsigned j = 0; j < 16; ++j) { const unsigned c = xb_ld(&bar[XB_XCNT(j)]); sum += c; cnt += (c > 0u) ? 1u : 0u; mine = (j == x) ? c : mine; }
        if (sum == G) break;
        __builtin_amdgcn_s_sleep(1);
        if ((++sp & 255u) == 0u) { if (xb_ld(&bar[XB_TMO])) break; if (sp > XB_SPIN_CAP) { atomicAdd(&bar[XB_TMO], 1u); break; } }
    }
    nloc = mine > 0u ? mine : 1u; nx = cnt > 0u ? cnt : 1u;
}
__device__ __forceinline__ void xcd_barrier(const XcdBarrier& b) {
    asm volatile("s_waitcnt vmcnt(0)" ::: "memory");
    __syncthreads();
    if (threadIdx.x == 0) {
        unsigned* bar = b.bar; unsigned bx = b.x; asm volatile("" : "+s"(bx));
        __builtin_amdgcn_s_waitcnt(0);
        unsigned nloc = b.st[0], nx = b.st[1];
        if (nloc == 0u) { xcd_barrier_complete(bar, bx, nloc, nx); b.st[0] = nloc; b.st[1] = nx; }
        const unsigned old = xb_add(&bar[XB_XSUB(bx)], 1u);
        const unsigned gen = old / nloc;
        if (old + 1u == (gen + 1u) * nloc) {
            __builtin_amdgcn_fence(__ATOMIC_RELEASE, "agent");
            asm volatile("s_waitcnt vmcnt(0)" ::: "memory");
            const unsigned og = xb_add(&bar[XB_TOP], 1u);
            const unsigned tg = og / nx;
            if (og + 1u == (tg + 1u) * nx) xb_add(&bar[XB_TOPGEN], 1u);
            else XB_SPIN(xb_ld(&bar[XB_TOPGEN]) == tg, bar);
            __builtin_amdgcn_fence(__ATOMIC_ACQUIRE, "agent");
            xb_add(&bar[XB_XGEN(bx)], 1u);
            asm volatile("s_waitcnt vmcnt(0)" ::: "memory");
        } else {
            XB_SPIN(xb_ld(&bar[XB_XGEN(bx)]) == gen, bar);
            __builtin_amdgcn_fence(__ATOMIC_ACQUIRE, "agent");
            asm volatile("s_waitcnt vmcnt(0)" ::: "memory");
        }
    }
    __syncthreads();
}

namespace pg8 {
constexpr int BM = 256, BK = 64, HALF = 128, HTB = HALF * BK * 2, STAGE_BYTES = 8 * HTB, NXCD = 8, WGM = 8;
__host__ __device__ __forceinline__ int lds_byte(int r, int c) { const int st = (r >> 4) * 2 + (c >> 5), rr = r & 15, cc = c & 31, ob = rr * 64 + cc * 2; return st * 1024 + (ob ^ (((ob >> 9) & 1) << 5)); }
__host__ __device__ __forceinline__ void stage_rc(int b, int& R, int& C) { const int st = b / 1024, sb = b % 1024, swz = sb ^ (((sb >> 9) & 1) << 5); R = (st >> 1) * 16 + swz / 64; C = (st & 1) * 32 + (swz % 64) / 2; }
__host__ __device__ __forceinline__ int perm32(int rho) { const int n = rho >> 4, i = rho & 15; return 8 * (i >> 2) + 4 * n + (i & 3); }

struct Unit { int pm, pn, kind; };
struct Gemm { const bf16_t* A0; const bf16_t* B0; const bf16_t* A1; const bf16_t* B1; int M, N, K; };

struct StaticOrder {
    int nM, nN, nwg, G, c;
    __device__ void init(int M, int N, int G_, int c_) { nM = M / BM; nN = N / BM; nwg = nM * nN; G = G_; c = c_; }
    __device__ bool next(int i, Unit& u) const {
        const long L = (long)i * G + c; if (L >= nwg) return false;
        int wgid = (int)L; { const int q = nwg / NXCD, r = nwg % NXCD, xcd = wgid % NXCD, off = wgid / NXCD; wgid = (xcd < r ? xcd * (q + 1) : r * (q + 1) + (xcd - r) * q) + off; }
        const int nig = WGM * nN, gid = wgid / nig, fm = gid * WGM, gsz = (nM - fm) < WGM ? (nM - fm) : WGM;
        u.pm = fm + ((wgid % nig) % gsz); u.pn = (wgid % nig) / gsz; u.kind = 0; return true;
    }
};
struct PairOrder {
    StaticOrder so;
    __device__ void init(int M, int N, int G_, int c_) { so.init(M, N, G_, c_); }
    __device__ bool next(int i, Unit& u) const { if (!so.next(i >> 1, u)) return false; u.kind = i & 1; return true; }
};

template <class Epi, class Sched, bool ALIGN_EPI = true, bool SP2 = true>
__device__ __forceinline__ void gemm_phase(LAS unsigned char* lds, const Gemm g, const Sched& S, const Epi& E) {
    const int tid = opaque_tid(), wid = __builtin_amdgcn_readfirstlane(tid >> 6), lane = tid & 63, wr = wid >> 2, wc = wid & 3, fr = lane & 15, fq = lane >> 4;
    const int K = g.K, nt = K / BK;
    unsigned voffA[2], voffB[2];
#pragma unroll
    for (int i = 0; i < 2; ++i) { int R, C; stage_rc(tid * 16 + i * 8192, R, C); const int Rb = Epi::PERM ? ((R & ~31) + perm32(R & 31)) : R;
        voffA[i] = (unsigned)(R * K + C) * 2u; voffB[i] = (unsigned)(Rb * K + C) * 2u; }
    const size_t kstep = (size_t)(BK * 2);
    const size_t hstep = (size_t)HALF * K * 2;
    const size_t tstep = 2 * hstep;
    const unsigned ldsw = (unsigned)wid * 1024u;
    const int aoff = lds_byte(wr * 64 + fr, fq * 8), boff = lds_byte(wc * 32 + fr, fq * 8);
#define PG8_SA(b, h) (((b) * 2 + (h)) * HTB)
#define PG8_SB(b, h) ((4 + (b) * 2 + (h)) * HTB)
#define PG8_STAGE(bufoff, gbase, voff) do { _Pragma("unroll") for (int _i = 0; _i < 2; ++_i) \
        __builtin_amdgcn_global_load_lds((const unsigned*)((const char*)(gbase) + (voff)[_i]), (LAS unsigned*)(lds + (bufoff) + ldsw + _i * 8192), 16, 0, 0); } while (0)
#define PG8_LDA(dst, b, h) do { _Pragma("unroll") for (int m = 0; m < 4; ++m) _Pragma("unroll") for (int k = 0; k < 2; ++k) dst[m][k] = *(const LAS bf16x8*)(lds + PG8_SA(b, h) + aoff + m * 2048 + k * 1024); } while (0)
#define PG8_LDB(dst, b, h) do { _Pragma("unroll") for (int n = 0; n < 2; ++n) _Pragma("unroll") for (int k = 0; k < 2; ++k) dst[n][k] = *(const LAS bf16x8*)(lds + PG8_SB(b, h) + boff + n * 2048 + k * 1024); } while (0)
#define PG8_MMA(ai, bj, At, Bt) do { __builtin_amdgcn_s_setprio(1); _Pragma("unroll") for (int m = 0; m < 4; ++m) _Pragma("unroll") for (int n = 0; n < 2; ++n) _Pragma("unroll") for (int k = 0; k < 2; ++k) \
        acc[ai][bj][m][n] = __builtin_amdgcn_mfma_f32_16x16x32_bf16(Bt[n][k], At[m][k], acc[ai][bj][m][n], 0, 0, 0); __builtin_amdgcn_s_setprio(0); } while (0)
#define PG8_WAIT_V(n) asm volatile("s_waitcnt vmcnt(" #n ")" ::: "memory")
#define PG8_WAIT_L(n) asm volatile("s_waitcnt lgkmcnt(" #n ")" ::: "memory")
#define PG8_BAR __builtin_amdgcn_s_barrier()
#define PG8_SCHED __builtin_amdgcn_sched_barrier(0)
    Unit cur, nxt; int ui = 0;
    if (!S.next(0, cur)) return;
    f32x4 acc[2][2][4][2];
#pragma unroll
    for (int a = 0; a < 2; ++a)
#pragma unroll
        for (int b = 0; b < 2; ++b)
#pragma unroll
            for (int m = 0; m < 4; ++m)
#pragma unroll
                for (int n = 0; n < 2; ++n) acc[a][b][m][n] = (f32x4){0.f, 0.f, 0.f, 0.f};
    bf16x8 At[4][2], B0[2][2], B1[2][2];
    const char* cA = (const char*)(cur.kind ? g.A1 : g.A0) + (size_t)cur.pm * tstep; const char* cB = (const char*)(cur.kind ? g.B1 : g.B0) + (size_t)cur.pn * tstep;
    if constexpr (SP2) {
        PG8_STAGE(PG8_SB(0, 0), cB, voffB); PG8_STAGE(PG8_SB(0, 1), cB + hstep, voffB); PG8_STAGE(PG8_SA(0, 0), cA, voffA); PG8_STAGE(PG8_SA(0, 1), cA + hstep, voffA);
        if (wr == 1) PG8_BAR;
        PG8_WAIT_V(2); PG8_BAR;
        PG8_STAGE(PG8_SB(1, 0), cB + kstep, voffB); PG8_STAGE(PG8_SA(1, 0), cA + kstep, voffA); PG8_STAGE(PG8_SB(1, 1), cB + hstep + kstep, voffB);
        PG8_WAIT_V(6); PG8_BAR;
    } else {
    PG8_STAGE(PG8_SB(0, 0), cB, voffB); PG8_STAGE(PG8_SA(0, 0), cA, voffA); PG8_STAGE(PG8_SB(0, 1), cB + hstep, voffB); PG8_STAGE(PG8_SA(0, 1), cA + hstep, voffA);
    if (wr == 1) PG8_BAR;
    PG8_WAIT_V(4); PG8_BAR;
    PG8_STAGE(PG8_SB(1, 0), cB + kstep, voffB); PG8_STAGE(PG8_SA(1, 0), cA + kstep, voffA); PG8_STAGE(PG8_SB(1, 1), cB + hstep + kstep, voffB);
    PG8_WAIT_V(6); PG8_BAR;
    }
    for (;;) {
        const bool has_next = S.next(ui + 1, nxt);
        const char* nA = has_next ? (const char*)(nxt.kind ? g.A1 : g.A0) + (size_t)nxt.pm * tstep : cA; const char* nB = has_next ? (const char*)(nxt.kind ? g.B1 : g.B0) + (size_t)nxt.pn * tstep : cB;
        for (int t = 0; t < nt; t += 2) {
            const bool last = (t == nt - 2);
            const char* a1 = cA + (size_t)(t + 1) * kstep;
            const char* a2 = last ? nA : cA + (size_t)(t + 2) * kstep; const char* b2 = last ? nB : cB + (size_t)(t + 2) * kstep;
            const char* a3 = a2 + kstep; const char* b3 = b2 + kstep;
            if constexpr (SP2) {
            PG8_LDB(B0, 0, 0); PG8_LDB(B1, 0, 1); PG8_SCHED; PG8_LDA(At, 0, 0); PG8_STAGE(PG8_SA(1, 1), a1 + hstep, voffA);
            PG8_WAIT_V(8); PG8_WAIT_L(0); PG8_BAR; PG8_MMA(0, 0, At, B0); PG8_MMA(0, 1, At, B1); PG8_BAR; PG8_SCHED;
            PG8_LDA(At, 0, 1); PG8_STAGE(PG8_SB(0, 0), b2, voffB); PG8_STAGE(PG8_SB(0, 1), b2 + hstep, voffB); PG8_STAGE(PG8_SA(0, 0), a2, voffA);
            PG8_WAIT_V(8); PG8_WAIT_L(0); PG8_BAR; PG8_MMA(1, 0, At, B0); PG8_MMA(1, 1, At, B1); PG8_BAR; PG8_SCHED;
            PG8_LDB(B0, 1, 0); PG8_LDB(B1, 1, 1); PG8_SCHED; PG8_LDA(At, 1, 0); PG8_STAGE(PG8_SA(0, 1), a2 + hstep, voffA);
            PG8_WAIT_V(8); PG8_WAIT_L(0); PG8_BAR; PG8_MMA(0, 0, At, B0); PG8_MMA(0, 1, At, B1); PG8_BAR; PG8_SCHED;
            PG8_LDA(At, 1, 1); PG8_STAGE(PG8_SB(1, 0), b3, voffB); PG8_STAGE(PG8_SB(1, 1), b3 + hstep, voffB); PG8_STAGE(PG8_SA(1, 0), a3, voffA);
            PG8_WAIT_V(8); PG8_WAIT_L(0); PG8_BAR; PG8_MMA(1, 0, At, B0); PG8_MMA(1, 1, At, B1); PG8_BAR; PG8_SCHED;
            } else {
            PG8_LDB(B0, 0, 0); PG8_SCHED; PG8_LDA(At, 0, 0); PG8_STAGE(PG8_SA(1, 1), a1 + hstep, voffA);
            PG8_WAIT_L(8); PG8_BAR; PG8_WAIT_L(0); PG8_MMA(0, 0, At, B0); PG8_BAR; PG8_SCHED;
            PG8_LDB(B1, 0, 1); PG8_STAGE(PG8_SB(0, 0), b2, voffB);
            PG8_BAR; PG8_WAIT_L(0); PG8_MMA(0, 1, At, B1); PG8_BAR;
            PG8_LDA(At, 0, 1); PG8_STAGE(PG8_SA(0, 0), a2, voffA);
            PG8_BAR; PG8_WAIT_L(0); PG8_MMA(1, 0, At, B0); PG8_BAR; PG8_SCHED;
            PG8_STAGE(PG8_SB(0, 1), b2 + hstep, voffB);
            PG8_WAIT_V(6); PG8_BAR; PG8_MMA(1, 1, At, B1); PG8_BAR;
            PG8_LDB(B0, 1, 0); PG8_SCHED; PG8_LDA(At, 1, 0); PG8_STAGE(PG8_SA(0, 1), a2 + hstep, voffA);
            PG8_WAIT_L(8); PG8_BAR; PG8_WAIT_L(0); PG8_MMA(0, 0, At, B0); PG8_BAR; PG8_SCHED;
            PG8_LDB(B1, 1, 1); PG8_STAGE(PG8_SB(1, 0), b3, voffB);
            PG8_BAR; PG8_WAIT_L(0); PG8_MMA(0, 1, At, B1); PG8_BAR;
            PG8_LDA(At, 1, 1); PG8_STAGE(PG8_SA(1, 0), a3, voffA);
            PG8_BAR; PG8_WAIT_L(0); PG8_MMA(1, 0, At, B0); PG8_BAR; PG8_SCHED;
            PG8_STAGE(PG8_SB(1, 1), b3 + hstep, voffB);
            PG8_WAIT_V(6); PG8_BAR; PG8_MMA(1, 1, At, B1); PG8_BAR;
            }
        }
        if constexpr (ALIGN_EPI) { if (wr == 0) PG8_BAR; }
        const bool keep = E(acc, cur, wr, wc, fr, fq);
        if (!has_next) break;
        if (!keep) {
#pragma unroll
        for (int a = 0; a < 2; ++a)
#pragma unroll
            for (int b = 0; b < 2; ++b)
#pragma unroll
                for (int m = 0; m < 4; ++m)
#pragma unroll
                    for (int n = 0; n < 2; ++n) acc[a][b][m][n] = (f32x4){0.f, 0.f, 0.f, 0.f};
        }
        cur = nxt; cA = nA; cB = nB; ++ui;
        if constexpr (ALIGN_EPI) { if (wr == 1) PG8_BAR; }
    }
    PG8_WAIT_V(0);
    if constexpr (!ALIGN_EPI) { if (wr == 0) PG8_BAR; }
    PG8_BAR;
#undef PG8_SA
#undef PG8_SB
#undef PG8_STAGE
#undef PG8_LDA
#undef PG8_LDB
#undef PG8_MMA
#undef PG8_WAIT_V
#undef PG8_WAIT_L
#undef PG8_BAR
#undef PG8_SCHED
}
}

typedef unsigned long long ssq_t;
constexpr float SSQ_SCALE = 16777216.0f;
__device__ __forceinline__ ssq_t ssq_fix(float s) { return (ssq_t)(s * SSQ_SCALE + 0.5f); }
__device__ __forceinline__ float row_rstd(const ssq_t* ss, int row) { return rsqrtf((float)ss[row] * (1.0f / SSQ_SCALE) * (1.0f / D) + EPS); }

struct EpiGU {
    static constexpr bool PERM = true;
    const ssq_t* ss; bf16_t* act;
    __device__ __forceinline__ bool operator()(f32x4 (&acc)[2][2][4][2], const pg8::Unit& u, int wr, int wc, int fr, int fq) const {
        const int row0 = u.pm * 256 + wr * 64 + fr, col0 = u.pn * 128 + wc * 32 + 8 * fq;
#pragma unroll
        for (int ai = 0; ai < 2; ++ai)
#pragma unroll
            for (int m = 0; m < 4; ++m) {
                const int row = row0 + ai * 128 + m * 16; const float r = row_rstd(ss, row);
                float o[8];
#pragma unroll
                for (int n = 0; n < 2; ++n)
#pragma unroll
                    for (int j = 0; j < 4; ++j) { const float gv = acc[ai][0][m][n][j] * r, uv = acc[ai][1][m][n][j] * r; o[n * 4 + j] = gv * sigmoidf_(gv) * uv; }
                u32x4 w; w.x = pk2(o[0], o[1]); w.y = pk2(o[2], o[3]); w.z = pk2(o[4], o[5]); w.w = pk2(o[6], o[7]);
                *(u32x4*)(act + (size_t)row * FF + col0) = w;
            }
        return false;
    }
};
struct EpiRes {
    static constexpr bool PERM = false;
    const float* xin32; bf16_t* xb; ssq_t* ss_out; float scale;
    __device__ __forceinline__ bool operator()(f32x4 (&acc)[2][2][4][2], const pg8::Unit& u, int wr, int wc, int fr, int fq) const {
        const int row0 = u.pm * 256 + wr * 64 + fr, col0 = u.pn * 256 + wc * 32 + 4 * fq;
#pragma unroll
        for (int ai = 0; ai < 2; ++ai)
#pragma unroll
            for (int m = 0; m < 4; ++m) {
                const int row = row0 + ai * 128 + m * 16; float s = 0.f;
#pragma unroll
                for (int bj = 0; bj < 2; ++bj)
#pragma unroll
                    for (int n = 0; n < 2; ++n) {
                        const size_t off = (size_t)row * D + col0 + bj * 128 + n * 16;
                        f32x4 xv;
                        if (xin32) xv = *(const f32x4*)(xin32 + off);
                        else { const u32x2 wi = *(const u32x2*)(xb + off); xv = (f32x4){bf_lo(wi.x), bf_hi(wi.x), bf_lo(wi.y), bf_hi(wi.y)}; }
                        xv = xv + acc[ai][bj][m][n] * scale;
                        u32x2 w; w.x = pk2(xv[0], xv[1]); w.y = pk2(xv[2], xv[3]); *(u32x2*)(xb + off) = w;
                        const float r0 = bf_lo(w.x), r1 = bf_hi(w.x), r2 = bf_lo(w.y), r3 = bf_hi(w.y);
                        s += (r0 * r0 + r1 * r1) + (r2 * r2 + r3 * r3);
                    }
                s += __shfl_xor(s, 16); s += __shfl_xor(s, 32);
                if (fq == 0) __hip_atomic_fetch_add(ss_out + row, ssq_fix(s), __ATOMIC_RELAXED, __HIP_MEMORY_SCOPE_AGENT);
            }
        return false;
    }
};
struct EpiP {
    static constexpr bool PERM = true;
    const ssq_t* ss; bf16_t* P;
    __device__ __forceinline__ bool operator()(f32x4 (&acc)[2][2][4][2], const pg8::Unit& u, int wr, int wc, int fr, int fq) const {
        const int row0 = u.pm * 256 + wr * 64 + fr, col0 = u.pn * 256 + wc * 32 + 8 * fq;
#pragma unroll
        for (int ai = 0; ai < 2; ++ai)
#pragma unroll
            for (int m = 0; m < 4; ++m) {
                const int row = row0 + ai * 128 + m * 16; const float r = row_rstd(ss, row);
#pragma unroll
                for (int bj = 0; bj < 2; ++bj) {
                    const f32x4 v0 = acc[ai][bj][m][0] * r, v1 = acc[ai][bj][m][1] * r;
                    u32x4 w; w.x = pk2(v0[0], v0[1]); w.y = pk2(v0[2], v0[3]); w.z = pk2(v1[0], v1[1]); w.w = pk2(v1[2], v1[3]);
                    *(u32x4*)(P + (size_t)row * INC + col0 + bj * 128) = w;
                }
            }
        return false;
    }
};
struct EpiMerge {
    static constexpr bool PERM = true;
    const bf16_t* P; bf16_t* mg;
    __device__ __forceinline__ bool operator()(f32x4 (&acc)[2][2][4][2], const pg8::Unit& u, int wr, int wc, int fr, int fq) const {
        const int row0 = u.pm * 256 + wr * 64 + fr, col0 = u.pn * 256 + wc * 32 + 8 * fq;
#pragma unroll
        for (int ai = 0; ai < 2; ++ai)
#pragma unroll
            for (int m = 0; m < 4; ++m) {
                const int row = row0 + ai * 128 + m * 16;
#pragma unroll
                for (int bj = 0; bj < 2; ++bj) {
                    const int col = col0 + bj * 128;
                    const u32x4 gb = *(const u32x4*)(P + (size_t)row * INC + PC_GB + col);
                    if (u.kind == 0) {
                        const u32x4 ga = *(const u32x4*)(P + (size_t)row * INC + PC_GA + col);
#pragma unroll
                        for (int q = 0; q < 4; ++q) {
                            const float a0 = bf_lo(ga[q]), a1 = bf_hi(ga[q]), b0 = bf_lo(gb[q]), b1 = bf_hi(gb[q]);
                            const float r0 = (1.0f + fexp(-b0)) * __builtin_amdgcn_rcpf(1.0f + fexp(-a0));
                            const float r1 = (1.0f + fexp(-b1)) * __builtin_amdgcn_rcpf(1.0f + fexp(-a1));
                            acc[ai][bj][m][q >> 1][(q & 1) * 2 + 0] *= r0; acc[ai][bj][m][q >> 1][(q & 1) * 2 + 1] *= r1;
                        }
                    } else {
                        float o[8];
#pragma unroll
                        for (int q = 0; q < 4; ++q) {
                            o[2 * q] = acc[ai][bj][m][q >> 1][(q & 1) * 2 + 0] * sigmoidf_(bf_lo(gb[q]));
                            o[2 * q + 1] = acc[ai][bj][m][q >> 1][(q & 1) * 2 + 1] * sigmoidf_(bf_hi(gb[q]));
                        }
                        u32x4 w; w.x = pk2(o[0], o[1]); w.y = pk2(o[2], o[3]); w.z = pk2(o[4], o[5]); w.w = pk2(o[6], o[7]);
                        *(u32x4*)(mg + (size_t)row * D + col) = w;
                    }
                }
            }
        return u.kind == 0;
    }
};

__device__ __forceinline__ void p0_item(const float* W, const float* gain, int K, int N, bf16_t* WT, int mode, LAS float* scr, int item, int lane) {
    const int nblk = N / 64, kb = item / nblk, nb = item % nblk, k0 = 64 * kb, n0 = 64 * nb;
    const int kr = lane >> 4, nc = (lane & 15) * 4;
    f32x4 v[16];
#pragma unroll
    for (int i = 0; i < 16; ++i) v[i] = __builtin_nontemporal_load((const f32x4*)(W + (size_t)(k0 + 4 * i + kr) * N + n0 + nc));
    if (gain) {
#pragma unroll
        for (int i = 0; i < 16; ++i) v[i] = v[i] * gain[k0 + 4 * i + kr];
    }
#pragma unroll
    for (int i = 0; i < 16; ++i) { LAS float* s = scr + (4 * i + kr) * 65 + nc; s[0] = v[i][0]; s[1] = v[i][1]; s[2] = v[i][2]; s[3] = v[i][3]; }
    LDS_WAIT();
    const int c = lane & 7;
    const int rbase = (mode == 0) ? n0 : ((n0 >> 7) * 256 + (mode == 2 ? 128 : 0) + (n0 & 127));
#pragma unroll
    for (int j = 0; j < 8; ++j) { const int n = (lane >> 3) + 8 * j; const LAS float* s = scr + (8 * c) * 65 + n;
        u32x4 o; o.x = pk2(s[0 * 65], s[1 * 65]); o.y = pk2(s[2 * 65], s[3 * 65]); o.z = pk2(s[4 * 65], s[5 * 65]); o.w = pk2(s[6 * 65], s[7 * 65]);
        *(u32x4*)(WT + (size_t)(rbase + n) * K + k0 + 8 * c) = o; }
    LDS_WAIT();
}

constexpr int I_FF = (D / 64) * (FF / 64), I_DN = (FF / 64) * (D / 64), I_IN = (D / 64) * (INC / 64), I_AB = (RGW / 64) * (D / 64), I_OUT = (D / 64) * (D / 64);
constexpr int I_A = 2 * I_FF + I_DN + I_IN;
constexpr int I_LAYER = 4 * I_FF + 2 * I_DN + I_IN + 2 * I_AB + I_OUT;
constexpr int I_P0 = 2 * I_FF;
constexpr int I_CUT2 = I_LAYER + 2 * I_FF;
__device__ __forceinline__ void convert_items(const Params& p, LAS unsigned char* lds, int lo, int hi, int wv, int nwv) {
    const int tid = opaque_tid(), lane = tid & 63, wave = tid >> 6;
    LAS float* scr = (LAS float*)(lds + wave * 16640);
    for (int it = lo + wv; it < hi; it += nwv) {
        const int l = it >= I_LAYER ? 1 : 0; int r = it - l * I_LAYER;
        bf16_t* wl = (bf16_t*)(p.ws + (size_t)l * SZ_LAYER);
        const float* W; const float* gain = nullptr; int K, N, mode = 0; size_t off;
        if (r < I_FF) { W = p.ffn1_wg + (size_t)l * D * FF; gain = p.ffn1_norm + l * D; K = D; N = FF; mode = 1; off = OFF_WGU1; }
        else if ((r -= I_FF) < I_FF) { W = p.ffn1_wu + (size_t)l * D * FF; gain = p.ffn1_norm + l * D; K = D; N = FF; mode = 2; off = OFF_WGU1; }
        else if ((r -= I_FF) < I_DN) { W = p.ffn1_wd + (size_t)l * D * FF; K = FF; N = D; off = OFF_WD1; }
        else if ((r -= I_DN) < I_IN) { W = p.w_in + (size_t)l * D * INC; gain = p.mix_norm + l * D; K = D; N = INC; off = OFF_WIN; }
        else if ((r -= I_IN) < I_AB) { W = p.wa + (size_t)l * RGW * D; K = RGW; N = D; off = OFF_WA; }
        else if ((r -= I_AB) < I_AB) { W = p.wb + (size_t)l * RGW * D; K = RGW; N = D; off = OFF_WB; }
        else if ((r -= I_AB) < I_OUT) { W = p.wout + (size_t)l * D * D; K = D; N = D; off = OFF_WOUT; }
        else if ((r -= I_OUT) < I_FF) { W = p.ffn2_wg + (size_t)l * D * FF; gain = p.ffn2_norm + l * D; K = D; N = FF; mode = 1; off = OFF_WGU2; }
        else if ((r -= I_FF) < I_FF) { W = p.ffn2_wu + (size_t)l * D * FF; gain = p.ffn2_norm + l * D; K = D; N = FF; mode = 2; off = OFF_WGU2; }
        else { r -= I_FF; W = p.ffn2_wd + (size_t)l * D * FF; K = FF; N = D; off = OFF_WD2; }
        p0_item(W, gain, K, N, (bf16_t*)((unsigned char*)wl + off), mode, scr, r, lane);
    }
}
__device__ __forceinline__ void tail_convert(const Params& p, LAS unsigned char* lds, int nunits, int G, int c, int lo, int hi) {
    const int rem = nunits % G, wave = opaque_tid() >> 6;
    if (rem != 0 && c < rem) return;
    convert_items(p, lds, lo, hi, (c - rem) * NWAVES + wave, (G - rem) * NWAVES);
}

__device__ __forceinline__ void p0_prologue(const Params& p, LAS unsigned char* lds, int G) {
    const int tid = opaque_tid(), lane = tid & 63, wave = tid >> 6;
    const int gw = blockIdx.x * NWAVES + wave, NGW = G * NWAVES;
    convert_items(p, lds, 0, I_P0, gw, NGW);
    ssq_t* ss = (ssq_t*)(p.ws + WS_SS); bf16_t* xb = (bf16_t*)(p.ws + WS_XB);
    for (int row = gw; row < T; row += NGW) {
        const f32x4* xr = (const f32x4*)(p.x + (size_t)row * D) + lane; u32x2* o = (u32x2*)(xb + (size_t)row * D) + lane; float s = 0.f;
#pragma unroll
        for (int j = 0; j < 8; ++j) { const f32x4 v = xr[64 * j]; s += (v[0] * v[0] + v[1] * v[1]) + (v[2] * v[2] + v[3] * v[3]); u32x2 w; w.x = pk2(v[0], v[1]); w.y = pk2(v[2], v[3]); o[64 * j] = w; }
        s = wave_sum(s); if (lane == 0) ss[row] = ssq_fix(s);
    }
    for (int i = blockIdx.x * NTHREADS + tid; i < 7 * T; i += G * NTHREADS) ss[T + i] = 0ull;
}

constexpr int H_QS = 272, H_TS = 144;
constexpr int HB_SZ = 62464, HB_QI = 0, HB_KI = 17408, HB_KIT = 34816, HB_VT = 53248;
constexpr int H_ST = 2 * HB_SZ, H_PM = H_ST + 17408, H_GT = H_PM + 9216;
static_assert(H_GT + 2 * 2048 <= LDS_BAR_OFF, "HGRN LDS image");
__device__ __forceinline__ void hgrn_chain(const Params& p, LAS unsigned char* lds, int layer, int chain, int dvh) {
    const int tid = opaque_tid(), lane = tid & 63, wave = __builtin_amdgcn_readfirstlane(tid >> 6), fr = lane & 15, fq = lane >> 4;
    const bf16_t* P = (const bf16_t*)(p.ws + WS_P);
    const int b = chain >> 4, h = (chain >> 1) & 7, dir = chain & 1;
    float* O = (float*)(p.ws + (dir ? WS_OB : WS_OF));
    const float* lbl = dir ? p.lbb : p.lbf;
    const int zc = (dir ? PC_ZB : PC_ZF) + h * 128;
    const int d = tid & 127, tg = tid >> 7;
    const int vs = tid & 63, vg = tid >> 6;
    float lb = 0.f;
    if (layer == 1) { const int ch = h * 128 + d; lb = sigmoidf_(lbl[RGW + ch] - lbl[ch]); }
    f32x4 Sacc[4];
#pragma unroll
    for (int i = 0; i < 4; ++i) Sacc[i] = (f32x4){0.f, 0.f, 0.f, 0.f};
    bf16_t zr[16], qr[16]; u32x4 vr0;
    float pb[16], kk_[16], qf[16]; u32x4 v0;
    const ptrdiff_t tstep_ = dir ? -(ptrdiff_t)INC : (ptrdiff_t)INC;
#define HG_TOK(c, j) ((size_t)b * SEQ + (dir ? ((SEQ / 64 - 1 - (c)) * 64 + 63 - (j)) : ((c) * 64 + (j))))
#define HG_LOAD(c) do { const bf16_t* zp_ = P + HG_TOK(c, tg * 16) * INC + zc + d; const bf16_t* qp_ = P + HG_TOK(c, tg * 16) * INC + PC_Q + h * 128 + d; \
        _Pragma("unroll") for (int i = 0; i < 16; ++i) { zr[i] = *zp_; qr[i] = *qp_; zp_ += tstep_; qp_ += tstep_; } \
        { const size_t tk = HG_TOK(c, vs); const bf16_t* vp = P + tk * INC + PC_I + h * 128 + dvh * 64 + vg * 8; vr0 = *(const u32x4*)vp; } } while (0)
#define HG_A1(g) do { LAS float* GT_ = (LAS float*)(lds + H_GT + (g) * 2048); float run = 1.f; \
        _Pragma("unroll") for (int i = 0; i < 16; ++i) { \
            const float z = fmaxf(bf1(zr[i]), -60.0f); const float e = fexp(-z), sg = __builtin_amdgcn_rcpf(1.0f + e); \
            const float f = lb + (1.0f - lb) * sg; kk_[i] = (1.0f - lb) * e * sg; run *= f; pb[i] = run; qf[i] = bf1(qr[i]); } \
        GT_[tg * 128 + d] = run; v0 = vr0; } while (0)
#define HG_A2(g, lb_) do { const LAS float* GT_ = (const LAS float*)(lds + H_GT + (g) * 2048); \
        const float g0 = GT_[d], g1 = GT_[128 + d], g2 = GT_[256 + d]; \
        const float den = (tg == 0) ? g0 * g1 : g1; \
        const float C = (tg >= 2) ? (tg == 3 ? g2 : 1.0f) : __builtin_amdgcn_rcpf(fmaxf(den, 1e-36f)); \
        unsigned kw[8]; \
        _Pragma("unroll") for (int i = 0; i < 16; i += 2) { \
            const float eq0 = fminf(fmaxf(pb[i] * C, 2.4e-35f), 4.15e34f), eq1 = fminf(fmaxf(pb[i + 1] * C, 2.4e-35f), 4.15e34f); \
            const float ek0 = __builtin_amdgcn_rcpf(eq0), ek1 = __builtin_amdgcn_rcpf(eq1); \
            const unsigned qw = pk2(qf[i] * eq0, qf[i + 1] * eq1); kw[i >> 1] = pk2(kk_[i] * ek0, kk_[i + 1] * ek1); \
            const int j = tg * 16 + i; \
            *(LAS bf16_t*)((lb_) + HB_QI + j * H_QS + d * 2) = (bf16_t)(qw & 0xffffu); *(LAS bf16_t*)((lb_) + HB_QI + (j + 1) * H_QS + d * 2) = (bf16_t)(qw >> 16); \
            *(LAS bf16_t*)((lb_) + HB_KI + j * H_QS + d * 2) = (bf16_t)(kw[i >> 1] & 0xffffu); *(LAS bf16_t*)((lb_) + HB_KI + (j + 1) * H_QS + d * 2) = (bf16_t)(kw[i >> 1] >> 16); } \
        u32x4 w0, w1; w0.x = kw[0]; w0.y = kw[1]; w0.z = kw[2]; w0.w = kw[3]; w1.x = kw[4]; w1.y = kw[5]; w1.z = kw[6]; w1.w = kw[7]; \
        *(LAS u32x4*)((lb_) + HB_KIT + d * H_TS + tg * 32) = w0; *(LAS u32x4*)((lb_) + HB_KIT + d * H_TS + tg * 32 + 16) = w1; \
        _Pragma("unroll") for (int q = 0; q < 4; ++q) { \
            *(LAS bf16_t*)((lb_) + HB_VT + (vg * 8 + 2 * q) * H_TS + vs * 2) = (bf16_t)(v0[q] & 0xffffu); *(LAS bf16_t*)((lb_) + HB_VT + (vg * 8 + 2 * q + 1) * H_TS + vs * 2) = (bf16_t)(v0[q] >> 16); } } while (0)
    HG_LOAD(0);
    HG_A1(0);
    HG_LOAD(1);
    LDS_BARRIER();
    HG_A2(0, lds);
    LDS_BARRIER();
    for (int c = 0; c < SEQ / 64; ++c) {
        const int cur = c & 1;
        LAS unsigned char* lc = lds + cur * HB_SZ;
        LAS unsigned char* ln = lds + (cur ^ 1) * HB_SZ;
        f32x4 eb, ec;
        {
            const LAS float* GT = (const LAS float*)(lds + H_GT + cur * 2048);
            const f32x4 g0 = *(const LAS f32x4*)(GT + wave * 16 + fq * 4), g1 = *(const LAS f32x4*)(GT + 128 + wave * 16 + fq * 4);
            const f32x4 g2 = *(const LAS f32x4*)(GT + 256 + wave * 16 + fq * 4), g3 = *(const LAS f32x4*)(GT + 384 + wave * 16 + fq * 4);
            eb = g0 * g1; ec = g2 * g3;
        }
#pragma unroll
        for (int dvt = 0; dvt < 4; ++dvt) {
            Sacc[dvt] = Sacc[dvt] * eb;
            u32x2 w; w.x = pk2(Sacc[dvt][0], Sacc[dvt][1]); w.y = pk2(Sacc[dvt][2], Sacc[dvt][3]);
            *(LAS u32x2*)(lds + H_ST + (dvt * 16 + fr) * H_QS + (wave * 16 + fq * 4) * 2) = w;
        }
        {
            const int tt = wave >> 1;
#pragma unroll
            for (int u = 0; u < 2; ++u) {
                const int st = (wave & 1) * 2 + u;
                f32x4 a4 = (f32x4){0.f, 0.f, 0.f, 0.f};
                if (st <= tt) {
#pragma unroll
                    for (int kk = 0; kk < 4; ++kk) {
                        const bf16x8 ka = *(const LAS bf16x8*)(lc + HB_KI + (st * 16 + fr) * H_QS + (kk * 32 + fq * 8) * 2);
                        const bf16x8 qb = *(const LAS bf16x8*)(lc + HB_QI + (tt * 16 + fr) * H_QS + (kk * 32 + fq * 8) * 2);
                        a4 = __builtin_amdgcn_mfma_f32_16x16x32_bf16(ka, qb, a4, 0, 0, 0);
                    }
                    const int t = tt * 16 + fr;
#pragma unroll
                    for (int j = 0; j < 4; ++j) { const int s = st * 16 + fq * 4 + j; a4[j] = (s <= t) ? a4[j] : 0.f; }
                }
                u32x2 w; w.x = pk2(a4[0], a4[1]); w.y = pk2(a4[2], a4[3]);
                *(LAS u32x2*)(lds + H_PM + (tt * 16 + fr) * H_TS + (st * 16 + fq * 4) * 2) = w;
            }
        }
        if (c + 1 < SEQ / 64) { HG_A1(cur ^ 1); if (c + 2 < SEQ / 64) HG_LOAD(c + 2); }
        LDS_BARRIER();
        {
            const int dvt = wave & 3;
            bf16x8 va[2], sa[4];
#pragma unroll
            for (int ks = 0; ks < 2; ++ks) va[ks] = *(const LAS bf16x8*)(lc + HB_VT + (dvt * 16 + fr) * H_TS + (ks * 32 + fq * 8) * 2);
#pragma unroll
            for (int kk = 0; kk < 4; ++kk) sa[kk] = *(const LAS bf16x8*)(lds + H_ST + (dvt * 16 + fr) * H_QS + (kk * 32 + fq * 8) * 2);
#pragma unroll
            for (int u = 0; u < 2; ++u) {
                const int tt = (wave >> 2) * 2 + u;
                f32x4 o4 = (f32x4){0.f, 0.f, 0.f, 0.f};
#pragma unroll
                for (int ks = 0; ks < 2; ++ks) { const bf16x8 pbf = *(const LAS bf16x8*)(lds + H_PM + (tt * 16 + fr) * H_TS + (ks * 32 + fq * 8) * 2); o4 = __builtin_amdgcn_mfma_f32_16x16x32_bf16(va[ks], pbf, o4, 0, 0, 0); }
#pragma unroll
                for (int kk = 0; kk < 4; ++kk) { const bf16x8 qb = *(const LAS bf16x8*)(lc + HB_QI + (tt * 16 + fr) * H_QS + (kk * 32 + fq * 8) * 2); o4 = __builtin_amdgcn_mfma_f32_16x16x32_bf16(sa[kk], qb, o4, 0, 0, 0); }
                *(f32x4*)(O + HG_TOK(c, tt * 16 + fr) * RGW + h * 128 + dvh * 64 + dvt * 16 + fq * 4) = o4;
            }
        }
        {
            bf16x8 ka[2];
#pragma unroll
            for (int ks = 0; ks < 2; ++ks) ka[ks] = *(const LAS bf16x8*)(lc + HB_KIT + (wave * 16 + fr) * H_TS + (ks * 32 + fq * 8) * 2);
#pragma unroll
            for (int dvt = 0; dvt < 4; ++dvt) {
#pragma unroll
                for (int ks = 0; ks < 2; ++ks) { const bf16x8 vb = *(const LAS bf16x8*)(lc + HB_VT + (dvt * 16 + fr) * H_TS + (ks * 32 + fq * 8) * 2); Sacc[dvt] = __builtin_amdgcn_mfma_f32_16x16x32_bf16(ka[ks], vb, Sacc[dvt], 0, 0, 0); }
                Sacc[dvt] = Sacc[dvt] * ec;
            }
        }
        if (c + 1 < SEQ / 64) HG_A2(cur ^ 1, ln);
        LDS_BARRIER();
    }
    __syncthreads();
#undef HG_A1
#undef HG_A2
#undef HG_LOAD
#undef HG_TOK
}

__device__ __forceinline__ void post_phase(const Params& p, int G, int layer) {
    const int tid = opaque_tid(), lane = tid & 63, wave = tid >> 6;
    const bf16_t* P = (const bf16_t*)(p.ws + WS_P); const float* OF = (const float*)(p.ws + WS_OF); const float* OB = (const float*)(p.ws + WS_OB);
    bf16_t* OA = (bf16_t*)(p.ws + WS_OA); const float* gain = p.rg_norm + layer * RGW;
    for (int pr = blockIdx.x * NWAVES + wave; pr < T * 8; pr += G * NWAVES) {
        const int tok = pr >> 3, h = pr & 7; const size_t off = (size_t)tok * RGW + h * 128 + 2 * lane;
        const f32x2 a = *(const f32x2*)(OF + off), bq = *(const f32x2*)(OB + off);
        const float o0 = a[0] + bq[0], o1 = a[1] + bq[1];
        const float s = wave_sum(o0 * o0 + o1 * o1); const float r = rsqrtf(s * (1.0f / 128.0f) + EPS);
        const unsigned gw_ = *(const unsigned*)(P + (size_t)tok * INC + PC_G + h * 128 + 2 * lane);
        const float g0 = bf_lo(gw_), g1 = bf_hi(gw_);
        const f32x2 gn = *(const f32x2*)(gain + h * 128 + 2 * lane);
        *(unsigned*)(OA + off) = pk2(o0 * r * gn[0] * (g0 * sigmoidf_(g0)), o1 * r * gn[1] * (g1 * sigmoidf_(g1)));
    }
}

constexpr int KST = 272;
constexpr int VST = 136;
__device__ __forceinline__ void attn_phase(const Params& p, LAS unsigned char* lds, int first, int stride, int layer) {
    const int tid = opaque_tid(), lane = tid & 63, wave = tid >> 6, fr = lane & 15, fq = lane >> 4;
    const bf16_t* P = (const bf16_t*)(p.ws + WS_P); bf16_t* OT = (bf16_t*)(p.ws + WS_OT);
    LAS unsigned char* Kt = lds;
    LAS unsigned char* Vt = lds + 64 * KST;
    for (int item = first; item < 4 * 16 * 8; item += stride) {
        const int h = item & 7, qb = (item >> 3) & 15, b = item >> 7, kvh = h >> 2;
        const float slope = exp2f(-(float)(h + 1)), sinkv = p.sink[layer * 8 + h];
        const int q0 = qb * 128, qw = q0 + wave * 16, qt = qw + fr;
        const size_t tokq = (size_t)b * SEQ + qt;
        bf16x8 Qf[4];
#pragma unroll
        for (int kk = 0; kk < 4; ++kk) Qf[kk] = *(const bf16x8*)(P + tokq * INC + PC_AQ + h * 128 + kk * 32 + fq * 8);
        f32x4 Oa[8];
#pragma unroll
        for (int i = 0; i < 8; ++i) Oa[i] = (f32x4){0.f, 0.f, 0.f, 0.f};
        float mrun = sinkv, lrun = 1.0f;
        const int kb_lo = (q0 - 128 < 0) ? 2 : 0, kb_hi = (q0 + 256 > SEQ) ? 4 : 6;
        const int skey = tid >> 4, sd0 = (tid & 15) * 8;
        u32x4 kreg[2], vreg[2];
#define AT_LOAD(kb_) do { const int k0_ = q0 - 128 + (kb_) * 64; _Pragma("unroll") for (int i = 0; i < 2; ++i) { const size_t tk = (size_t)b * SEQ + k0_ + skey + i * 32; \
            kreg[i] = *(const u32x4*)(P + tk * INC + PC_AK + kvh * 128 + sd0); vreg[i] = *(const u32x4*)(P + tk * INC + PC_AV + kvh * 128 + sd0); } } while (0)
        AT_LOAD(kb_lo);
        for (int kb = kb_lo; kb < kb_hi; ++kb) {
            const int k0 = q0 - 128 + kb * 64;
            __syncthreads();
#pragma unroll
            for (int i = 0; i < 2; ++i) {
                const int key = skey + i * 32;
                *(LAS u32x4*)(Kt + key * KST + sd0 * 2) = kreg[i];
#pragma unroll
                for (int q = 0; q < 4; ++q) {
                    *(LAS bf16_t*)(Vt + (sd0 + 2 * q) * VST + key * 2) = (bf16_t)(vreg[i][q] & 0xffffu);
                    *(LAS bf16_t*)(Vt + (sd0 + 2 * q + 1) * VST + key * 2) = (bf16_t)(vreg[i][q] >> 16);
                }
            }
            __syncthreads();
            if (kb + 1 < kb_hi) AT_LOAD(kb + 1);
            if (k0 + 63 < qw - 128 || k0 > qw + 15 + 128) continue;
            f32x4 Sa[4];
#pragma unroll
            for (int t = 0; t < 4; ++t) {
                Sa[t] = (f32x4){0.f, 0.f, 0.f, 0.f};
#pragma unroll
                for (int kk = 0; kk < 4; ++kk) {
                    const bf16x8 kf = *(const LAS bf16x8*)(Kt + (t * 16 + fr) * KST + (kk * 32 + fq * 8) * 2);
                    Sa[t] = __builtin_amdgcn_mfma_f32_16x16x32_bf16(kf, Qf[kk], Sa[t], 0, 0, 0);
                }
            }
            float mloc = -INFINITY;
#pragma unroll
            for (int t = 0; t < 4; ++t)
#pragma unroll
                for (int j = 0; j < 4; ++j) {
                    const int kt = k0 + t * 16 + fq * 4 + j; const int rel = kt - qt; const int ar = rel < 0 ? -rel : rel;
                    float s = Sa[t][j] * 0.08838834764831845f - slope * (float)ar;
                    s = (ar <= 128) ? s : -INFINITY;
                    Sa[t][j] = s; mloc = fmaxf(mloc, s);
                }
            mloc = fmaxf(mloc, __shfl_xor(mloc, 16)); mloc = fmaxf(mloc, __shfl_xor(mloc, 32));
            const float mnew = fmaxf(mrun, mloc), alpha = fexp(mrun - mnew);
            float lsum = 0.f;
#pragma unroll
            for (int t = 0; t < 4; ++t)
#pragma unroll
                for (int j = 0; j < 4; ++j) { const float e = fexp(Sa[t][j] - mnew); Sa[t][j] = e; lsum += e; }
            lsum += __shfl_xor(lsum, 16); lsum += __shfl_xor(lsum, 32);
            lrun = lrun * alpha + lsum; mrun = mnew;
#pragma unroll
            for (int i = 0; i < 8; ++i) Oa[i] = Oa[i] * alpha;
            bf16x8 Pf[2];
#pragma unroll
            for (int s2 = 0; s2 < 2; ++s2) {
                u32x4 w; w.x = pk2(Sa[2 * s2][0], Sa[2 * s2][1]); w.y = pk2(Sa[2 * s2][2], Sa[2 * s2][3]); w.z = pk2(Sa[2 * s2 + 1][0], Sa[2 * s2 + 1][1]); w.w = pk2(Sa[2 * s2 + 1][2], Sa[2 * s2 + 1][3]);
                Pf[s2] = __builtin_bit_cast(bf16x8, w);
            }
#pragma unroll
            for (int dt = 0; dt < 8; ++dt)
#pragma unroll
                for (int s2 = 0; s2 < 2; ++s2) {
                    const LAS unsigned char* vp = Vt + (dt * 16 + fr) * VST + (s2 * 32 + fq * 4) * 2;
                    const u32x2 lo = *(const LAS u32x2*)vp, hi = *(const LAS u32x2*)(vp + 32);
                    u32x4 w; w.x = lo.x; w.y = lo.y; w.z = hi.x; w.w = hi.y;
                    Oa[dt] = __builtin_amdgcn_mfma_f32_16x16x32_bf16(__builtin_bit_cast(bf16x8, w), Pf[s2], Oa[dt], 0, 0, 0);
                }
        }
        const float inv = 1.0f / lrun;
#pragma unroll
        for (int dt = 0; dt < 8; ++dt) {
            u32x2 w; w.x = pk2(Oa[dt][0] * inv, Oa[dt][1] * inv); w.y = pk2(Oa[dt][2] * inv, Oa[dt][3] * inv);
            *(u32x2*)(OT + tokq * RGW + h * 128 + dt * 16 + fq * 4) = w;
        }
    }
}

__device__ __forceinline__ void final_phase(const Params& p, int G) {
    const int tid = opaque_tid(), lane = tid & 63, wave = tid >> 6;
    const bf16_t* XBp = (const bf16_t*)(p.ws + WS_XB); const ssq_t* ss = (const ssq_t*)(p.ws + WS_SS) + 6 * T;
    for (int row = blockIdx.x * NWAVES + wave; row < T; row += G * NWAVES) {
        const float r = row_rstd(ss, row);
        const u32x2* xr = (const u32x2*)(XBp + (size_t)row * D) + lane; const f32x4* gr = (const f32x4*)p.final_norm + lane; f32x4* o = (f32x4*)(p.out + (size_t)row * D) + lane;
#pragma unroll
        for (int j = 0; j < 8; ++j) { const u32x2 w = xr[64 * j]; const f32x4 xv = (f32x4){bf_lo(w.x), bf_hi(w.x), bf_lo(w.y), bf_hi(w.y)}; __builtin_nontemporal_store(xv * r * gr[64 * j], o + 64 * j); }
    }
}

__global__ void __launch_bounds__(NTHREADS, 2) fwd_megakernel(Params p) {
    extern __shared__ __attribute__((aligned(16))) unsigned char lds_raw[];
    LAS unsigned char* lds = (LAS unsigned char*)lds_raw;
    cg::grid_group grid = cg::this_grid();
    if (threadIdx.x < 4) ((LAS unsigned*)(lds + LDS_BAR_OFF))[threadIdx.x] = 0u;
    __syncthreads();
    XcdBarrier xbar = xcd_barrier_post((unsigned*)(p.ws + WS_BAR), (volatile LAS unsigned*)(lds + LDS_BAR_OFF));
    if (p.ws == nullptr) grid.sync();
#define GSYNC() xcd_barrier(xbar)
    const int G = gridDim.x, c = blockIdx.x;
    unsigned char* ws = p.ws;
    float* X = (float*)(ws + WS_X); bf16_t* XB = (bf16_t*)(ws + WS_XB); ssq_t* SS = (ssq_t*)(ws + WS_SS);
    bf16_t* ACT = (bf16_t*)(ws + WS_ACT); bf16_t* Pb = (bf16_t*)(ws + WS_P);
    bf16_t* OA = (bf16_t*)(ws + WS_OA); bf16_t* OT = (bf16_t*)(ws + WS_OT); bf16_t* MG = (bf16_t*)(ws + WS_MG);

#ifndef PHMASK
#define PHMASK 0xffff
#endif
#define PH(n) ((PHMASK >> (n)) & 1)
#if PH(0)
    p0_prologue(p, lds, G);
#endif
    GSYNC();
#pragma unroll 1
    for (int l = 0; l < 2; ++l) {
        const unsigned char* wl = ws + (size_t)l * SZ_LAYER;
        const ssq_t* ss_ffn1 = SS + (3 * l + 0) * T; ssq_t* ss_mix = SS + (3 * l + 1) * T; ssq_t* ss_ffn2 = SS + (3 * l + 2) * T; ssq_t* ss_next = SS + (3 * l + 3) * T;
#if PH(1)
        { pg8::Gemm g{XB, (const bf16_t*)(wl + OFF_WGU1), XB, (const bf16_t*)(wl + OFF_WGU1), T, 2 * FF, D}; pg8::StaticOrder S; S.init(T, 2 * FF, G, c);
          EpiGU E{ss_ffn1, ACT}; pg8::gemm_phase(lds, g, S, E); }
        if (l == 0) tail_convert(p, lds, (T / 256) * (2 * FF / 256), G, c, I_P0, I_A);
#endif
        GSYNC();
#if PH(2)
        { pg8::Gemm g{ACT, (const bf16_t*)(wl + OFF_WD1), ACT, (const bf16_t*)(wl + OFF_WD1), T, D, FF}; pg8::StaticOrder S; S.init(T, D, G, c);
          EpiRes E{l == 0 ? p.x : nullptr, XB, ss_mix, 0.5f}; pg8::gemm_phase(lds, g, S, E); }
#endif
        GSYNC();
#if PH(3)
        { pg8::Gemm g{XB, (const bf16_t*)(wl + OFF_WIN), XB, (const bf16_t*)(wl + OFF_WIN), T, INC, D}; pg8::StaticOrder S; S.init(T, INC, G, c);
          EpiP E{ss_mix, Pb}; pg8::gemm_phase(lds, g, S, E); }
        tail_convert(p, lds, (T / 256) * (INC / 256), G, c, l * I_LAYER + I_A, (l + 1) * I_LAYER);
#endif
        GSYNC();
#if PH(4)
        { const int hw = (G >= 256) ? 128 : 0;
          if (hw == 0 || c < hw) for (int ch = c; ch < 128; ch += (hw ? 128 : G)) hgrn_chain(p, lds, l, ch >> 1, ch & 1);
          if (c >= hw) { attn_phase(p, lds, c - hw, G - hw, l); __syncthreads(); if (l == 0) convert_items(p, lds, I_LAYER, I_CUT2, (c - hw) * NWAVES + (opaque_tid() >> 6), (G - hw) * NWAVES); } }
#endif
        GSYNC();
#if PH(6)
        post_phase(p, G, l);
#endif
        GSYNC();
#if PH(7)
        { pg8::Gemm g{OA, (const bf16_t*)(wl + OFF_WA), OT, (const bf16_t*)(wl + OFF_WB), T, D, RGW}; pg8::PairOrder S; S.init(T, D, G, c);
          EpiMerge E{Pb, MG}; pg8::gemm_phase(lds, g, S, E); }
#endif
        GSYNC();
#if PH(8)
        { pg8::Gemm g{MG, (const bf16_t*)(wl + OFF_WOUT), MG, (const bf16_t*)(wl + OFF_WOUT), T, D, D}; pg8::StaticOrder S; S.init(T, D, G, c);
          EpiRes E{nullptr, XB, ss_ffn2, 1.0f}; pg8::gemm_phase(lds, g, S, E); }
#endif
        GSYNC();
#if PH(9)
        { pg8::Gemm g{XB, (const bf16_t*)(wl + OFF_WGU2), XB, (const bf16_t*)(wl + OFF_WGU2), T, 2 * FF, D}; pg8::StaticOrder S; S.init(T, 2 * FF, G, c);
          EpiGU E{ss_ffn2, ACT}; pg8::gemm_phase(lds, g, S, E); }
        if (l == 0) tail_convert(p, lds, (T / 256) * (2 * FF / 256), G, c, I_CUT2, I_LAYER + I_A);
#endif
        GSYNC();
#if PH(10)
        { pg8::Gemm g{ACT, (const bf16_t*)(wl + OFF_WD2), ACT, (const bf16_t*)(wl + OFF_WD2), T, D, FF}; pg8::StaticOrder S; S.init(T, D, G, c);
          EpiRes E{nullptr, XB, ss_next, 0.5f}; pg8::gemm_phase(lds, g, S, E); }
#endif
        GSYNC();
    }
#if PH(11)
    final_phase(p, G);
#endif
}

extern "C" void kernel_launch(void* const* d_in, const int* in_sizes, int n_in, void* d_out, int out_size, void* d_ws, size_t ws_size, hipStream_t stream) {
    static int grid_blocks = 0;
    if (grid_blocks == 0) {
        if (n_in != 19 || ws_size < WS_END) { fprintf(stderr, "kernel_launch: unexpected n_in %d / ws_size %zu (need %zu)\n", n_in, ws_size, (size_t)WS_END); grid_blocks = -1; return; }
        int dev = 0, cus = 0, per_cu = 0;
        hipGetDevice(&dev);
        hipDeviceGetAttribute(&cus, hipDeviceAttributeMultiprocessorCount, dev);
        hipFuncSetAttribute((const void*)fwd_megakernel, hipFuncAttributeMaxDynamicSharedMemorySize, LDS_BYTES);
        hipOccupancyMaxActiveBlocksPerMultiprocessor(&per_cu, (const void*)fwd_megakernel, NTHREADS, LDS_BYTES);
        if (per_cu < 1) { fprintf(stderr, "kernel_launch: occupancy query says %d blocks/CU\n", per_cu); per_cu = 1; }
        grid_blocks = cus * 1;
    }
    if (grid_blocks < 0) return;
    Params p{};
    p.x = (const float*)d_in[0]; p.ffn1_norm = (const float*)d_in[1]; p.ffn1_wg = (const float*)d_in[2]; p.ffn1_wu = (const float*)d_in[3]; p.ffn1_wd = (const float*)d_in[4];
    p.mix_norm = (const float*)d_in[5]; p.w_in = (const float*)d_in[6]; p.lbf = (const float*)d_in[7]; p.lbb = (const float*)d_in[8]; p.rg_norm = (const float*)d_in[9];
    p.sink = (const float*)d_in[10]; p.wa = (const float*)d_in[11]; p.wb = (const float*)d_in[12]; p.wout = (const float*)d_in[13];
    p.ffn2_norm = (const float*)d_in[14]; p.ffn2_wg = (const float*)d_in[15]; p.ffn2_wu = (const float*)d_in[16]; p.ffn2_wd = (const float*)d_in[17]; p.final_norm = (const float*)d_in[18];
    p.out = (float*)d_out; p.ws = (unsigned char*)d_ws;
    if (hipMemsetAsync((char*)d_ws + WS_BAR, 0, 16384, stream) != hipSuccess) { fprintf(stderr, "kernel_launch: memset failed\n"); return; }
    void* args[] = {&p};
    hipError_t e = hipLaunchCooperativeKernel((const void*)fwd_megakernel, dim3(grid_blocks), dim3(NTHREADS), args, LDS_BYTES, stream);
    if (e != hipSuccess) fprintf(stderr, "cooperative launch failed: %s (grid %d)\n", hipGetErrorString(e), grid_blocks);
}
```

```cpp
#include <hip/hip_runtime.h>
#include <hip/hip_cooperative_groups.h>
#include <cstdio>
namespace cg = cooperative_groups;

#define LAS __attribute__((address_space(3)))
typedef unsigned short bf16_t;
typedef short bf16x8 __attribute__((ext_vector_type(8)));
typedef short bf16x4 __attribute__((ext_vector_type(4)));
typedef float f32x4 __attribute__((ext_vector_type(4)));
typedef float f32x2 __attribute__((ext_vector_type(2)));
typedef unsigned u32x4 __attribute__((ext_vector_type(4)));
typedef unsigned u32x2 __attribute__((ext_vector_type(2)));

constexpr int T = 8192, D = 2048, FF = 5632, INC = 10752, SEQ = 2048, RGW = 1024;
constexpr float EPS = 1e-6f;
constexpr int NTHREADS = 512, NWAVES = 8;
constexpr int LDS_BAR_OFF = 155648;
constexpr int LDS_BYTES = LDS_BAR_OFF + 16;

constexpr int PC_Q = 0, PC_I = 1024, PC_ZF = 2048, PC_ZB = 3072, PC_G = 4096, PC_AQ = 5120, PC_AK = 6144, PC_AV = 6400, PC_GA = 6656, PC_GB = 8704;

constexpr size_t SZ_WGU = (size_t)2 * FF * D * 2, SZ_WD = (size_t)D * FF * 2, SZ_WIN = (size_t)INC * D * 2, SZ_WAB = (size_t)D * RGW * 2, SZ_WOUT = (size_t)D * D * 2;
constexpr size_t OFF_WGU1 = 0, OFF_WD1 = OFF_WGU1 + SZ_WGU, OFF_WIN = OFF_WD1 + SZ_WD, OFF_WA = OFF_WIN + SZ_WIN, OFF_WB = OFF_WA + SZ_WAB, OFF_WOUT = OFF_WB + SZ_WAB,
                 OFF_WGU2 = OFF_WOUT + SZ_WOUT, OFF_WD2 = OFF_WGU2 + SZ_WGU, SZ_LAYER = OFF_WD2 + SZ_WD;
constexpr size_t WS_X = 2 * SZ_LAYER, WS_XB = WS_X + (size_t)T * D * 4, WS_SS = WS_XB + (size_t)T * D * 2, WS_BAR = WS_SS + (size_t)8 * T * 8, WS_REG = WS_BAR + 16384;
constexpr size_t WS_ACT = WS_REG;
constexpr size_t WS_P = WS_REG;
constexpr size_t WS_OF = WS_P + (size_t)T * INC * 2;
constexpr size_t WS_OB = WS_OF + (size_t)T * RGW * 4;
constexpr size_t WS_OA = WS_OB + (size_t)T * RGW * 4;
constexpr size_t WS_OT = WS_OA + (size_t)T * RGW * 2;
constexpr size_t WS_MG = WS_OT + (size_t)T * RGW * 2;
constexpr size_t WS_END = WS_MG + (size_t)T * D * 2;

struct Params {
    const float* x; const float* ffn1_norm; const float* ffn1_wg; const float* ffn1_wu; const float* ffn1_wd; const float* mix_norm; const float* w_in;
    const float* lbf; const float* lbb; const float* rg_norm; const float* sink; const float* wa; const float* wb; const float* wout;
    const float* ffn2_norm; const float* ffn2_wg; const float* ffn2_wu; const float* ffn2_wd; const float* final_norm;
    float* out; unsigned char* ws;
};

__device__ __forceinline__ unsigned pk2(float lo, float hi) { unsigned r; asm("v_cvt_pk_bf16_f32 %0, %1, %2" : "=v"(r) : "v"(lo), "v"(hi)); return r; }
__device__ __forceinline__ float bf_lo(unsigned w) { return __uint_as_float(w << 16); }
__device__ __forceinline__ float bf_hi(unsigned w) { return __uint_as_float(w & 0xffff0000u); }
__device__ __forceinline__ float bf1(bf16_t w) { return __uint_as_float(((unsigned)w) << 16); }
__device__ __forceinline__ float wave_sum(float v) {
#pragma unroll
    for (int o = 1; o < 64; o <<= 1) v += __shfl_xor(v, o);
    return v;
}
__device__ __forceinline__ float fexp(float v) { return __builtin_amdgcn_exp2f(v * 1.4426950408889634f); }
__device__ __forceinline__ float flog(float v) { return __builtin_amdgcn_logf(v) * 0.6931471805599453f; }
__device__ __forceinline__ float sigmoidf_(float v) { return __builtin_amdgcn_rcpf(1.0f + fexp(-v)); }
#define LDS_WAIT() asm volatile("s_waitcnt lgkmcnt(0)" ::: "memory")
#define LDS_BARRIER() do { asm volatile("s_waitcnt lgkmcnt(0)" ::: "memory"); __builtin_amdgcn_s_barrier(); asm volatile("" ::: "memory"); } while (0)
__device__ __forceinline__ int opaque_tid() { int t = threadIdx.x; asm volatile("" : "+v"(t)); return t; }


#define XB_TMO      128
#define XB_XCNT(j)  (256  + 64 * (j))
#define XB_XSUB(j)  (1280 + 64 * (j))
#define XB_XGEN(j)  (2304 + 64 * (j))
#define XB_TOP      3328
#define XB_TOPGEN   3392
#define XCD_BAR_WORDS 3456
#define XB_SPIN_CAP (1u << 22)
__device__ __forceinline__ unsigned xb_ld(unsigned* p)              { return __hip_atomic_load(p, __ATOMIC_RELAXED, __HIP_MEMORY_SCOPE_AGENT); }
__device__ __forceinline__ unsigned xb_add(unsigned* p, unsigned v) { return __hip_atomic_fetch_add(p, v, __ATOMIC_RELAXED, __HIP_MEMORY_SCOPE_AGENT); }
__device__ __forceinline__ unsigned xb_xcc_id() { return (unsigned)__builtin_amdgcn_s_getreg((3 << 11) | 20) & 0xFu; }
#define XB_SPIN(cond, bar) do { unsigned _sp = 0; while (cond) { __builtin_amdgcn_s_sleep(1); \
    if ((++_sp & 255u) == 0u) { if (xb_ld(&(bar)[XB_TMO])) break; if (_sp > XB_SPIN_CAP) { atomicAdd(&(bar)[XB_TMO], 1u); break; } } } } while (0)
struct XcdBarrier { unsigned* bar; unsigned x; volatile LAS unsigned* st; };
__device__ __forceinline__ XcdBarrier xcd_barrier_post(unsigned* bar, volatile LAS unsigned* st) {
    XcdBarrier b; b.bar = bar; b.x = xb_xcc_id(); b.st = st;
    if (threadIdx.x == 0) (void)xb_add(&bar[XB_XCNT(b.x)], 1u);
    return b;
}
__device__ __forceinline__ void xcd_barrier_complete(unsigned* bar, unsigned x, unsigned& nloc, unsigned& nx) {
    const unsigned G = gridDim.x * gridDim.y * gridDim.z;
    unsigned sum, cnt, mine, sp = 0u;
    for (;;) {
        sum = 0u; cnt = 0u; mine = 0u;
#pragma unroll
        for (unsigned j = 0; j < 16; ++j) { const unsigned c = xb_ld(&bar[XB_XCNT(j)]); sum += c; cnt += (c > 0u) ? 1u : 0u; mine = (j == x) ? c : mine; }
        if (sum == G) break;
        __builtin_amdgcn_s_sleep(1);
        if ((++sp & 255u) == 0u) { if (xb_ld(&bar[XB_TMO])) break; if (sp > XB_SPIN_CAP) { atomicAdd(&bar[XB_TMO], 1u); break; } }
    }
    nloc = mine > 0u ? mine : 1u; nx = cnt > 0u ? cnt : 1u;
}
__device__ __forceinline__ void xcd_barrier(const XcdBarrier& b) {
    asm volatile("s_waitcnt vmcnt(0)" ::: "memory");
    __syncthreads();
    if (threadIdx.x == 0) {
        unsigned* bar = b.bar; unsigned bx = b.x; asm volatile("" : "+s"(bx));
        __builtin_amdgcn_s_waitcnt(0);
        unsigned nloc = b.st[0], nx = b.st[1];
        if (nloc == 0u) { xcd_barrier_complete(bar, bx, nloc, nx); b.st[0] = nloc; b.st[1] = nx; }
        const unsigned old = xb_add(&bar[XB_XSUB(bx)], 1u);
        const unsigned gen = old / nloc;
        if (old + 1u == (gen + 1u) * nloc) {
            __builtin_amdgcn_fence(__ATOMIC_RELEASE, "agent");
            asm volatile("s_waitcnt vmcnt(0)" ::: "memory");
            const unsigned og = xb_add(&bar[XB_TOP], 1u);
            const unsigned tg = og / nx;
            if (og + 1u == (tg + 1u) * nx) xb_add(&bar[XB_TOPGEN], 1u);
            else XB_SPIN(xb_ld(&bar[XB_TOPGEN]) == tg, bar);
            __builtin_amdgcn_fence(__ATOMIC_ACQUIRE, "agent");
            xb_add(&bar[XB_XGEN(bx)], 1u);
            asm volatile("s_waitcnt vmcnt(0)" ::: "memory");
        } else {
            XB_SPIN(xb_ld(&bar[XB_XGEN(bx)]) == gen, bar);
            __builtin_amdgcn_fence(__ATOMIC_ACQUIRE, "agent");
            asm volatile("s_waitcnt vmcnt(0)" ::: "memory");
        }
    }
    __syncthreads();
}

namespace pg8 {
constexpr int BM = 256, BK = 64, HALF = 128, HTB = HALF * BK * 2, STAGE_BYTES = 8 * HTB, NXCD = 8, WGM = 8;
__host__ __device__ __forceinline__ int lds_byte(int r, int c) { const int st = (r >> 4) * 2 + (c >> 5), rr = r & 15, cc = c & 31, ob = rr * 64 + cc * 2; return st * 1024 + (ob ^ (((ob >> 9) & 1) << 5)); }
__host__ __device__ __forceinline__ void stage_rc(int b, int& R, int& C) { const int st = b / 1024, sb = b % 1024, swz = sb ^ (((sb >> 9) & 1) << 5); R = (st >> 1) * 16 + swz / 64; C = (st & 1) * 32 + (swz % 64) / 2; }
__host__ __device__ __forceinline__ int perm32(int rho) { const int n = rho >> 4, i = rho & 15; return 8 * (i >> 2) + 4 * n + (i & 3); }

struct Unit { int pm, pn, kind; };
struct Gemm { const bf16_t* A0; const bf16_t* B0; const bf16_t* A1; const bf16_t* B1; int M, N, K; };

struct StaticOrder {
    int nM, nN, nwg, G, c;
    __device__ void init(int M, int N, int G_, int c_) { nM = M / BM; nN = N / BM; nwg = nM * nN; G = G_; c = c_; }
    __device__ bool next(int i, Unit& u) const {
        const long L = (long)i * G + c; if (L >= nwg) return false;
        int wgid = (int)L; { const int q = nwg / NXCD, r = nwg % NXCD, xcd = wgid % NXCD, off = wgid / NXCD; wgid = (xcd < r ? xcd * (q + 1) : r * (q + 1) + (xcd - r) * q) + off; }
        const int nig = WGM * nN, gid = wgid / nig, fm = gid * WGM, gsz = (nM - fm) < WGM ? (nM - fm) : WGM;
        u.pm = fm + ((wgid % nig) % gsz); u.pn = (wgid % nig) / gsz; u.kind = 0; return true;
    }
};
struct PairOrder {
    StaticOrder so;
    __device__ void init(int M, int N, int G_, int c_) { so.init(M, N, G_, c_); }
    __device__ bool next(int i, Unit& u) const { if (!so.next(i >> 1, u)) return false; u.kind = i & 1; return true; }
};

template <class Epi, class Sched, bool ALIGN_EPI = true, bool SP2 = true>
__device__ __forceinline__ void gemm_phase(LAS unsigned char* lds, const Gemm g, const Sched& S, const Epi& E) {
    const int tid = opaque_tid(), wid = __builtin_amdgcn_readfirstlane(tid >> 6), lane = tid & 63, wr = wid >> 2, wc = wid & 3, fr = lane & 15, fq = lane >> 4;
    const int K = g.K, nt = K / BK;
    unsigned voffA[2], voffB[2];
#pragma unroll
    for (int i = 0; i < 2; ++i) { int R, C; stage_rc(tid * 16 + i * 8192, R, C); const int Rb = Epi::PERM ? ((R & ~31) + perm32(R & 31)) : R;
        voffA[i] = (unsigned)(R * K + C) * 2u; voffB[i] = (unsigned)(Rb * K + C) * 2u; }
    const size_t kstep = (size_t)(BK * 2);
    const size_t hstep = (size_t)HALF * K * 2;
    const size_t tstep = 2 * hstep;
    const unsigned ldsw = (unsigned)wid * 1024u;
    const int aoff = lds_byte(wr * 64 + fr, fq * 8), boff = lds_byte(wc * 32 + fr, fq * 8);
#define PG8_SA(b, h) (((b) * 2 + (h)) * HTB)
#define PG8_SB(b, h) ((4 + (b) * 2 + (h)) * HTB)
#define PG8_STAGE(bufoff, gbase, voff) do { _Pragma("unroll") for (int _i = 0; _i < 2; ++_i) \
        __builtin_amdgcn_global_load_lds((const unsigned*)((const char*)(gbase) + (voff)[_i]), (LAS unsigned*)(lds + (bufoff) + ldsw + _i * 8192), 16, 0, 0); } while (0)
#define PG8_LDA(dst, b, h) do { _Pragma("unroll") for (int m = 0; m < 4; ++m) _Pragma("unroll") for (int k = 0; k < 2; ++k) dst[m][k] = *(const LAS bf16x8*)(lds + PG8_SA(b, h) + aoff + m * 2048 + k * 1024); } while (0)
#define PG8_LDB(dst, b, h) do { _Pragma("unroll") for (int n = 0; n < 2; ++n) _Pragma("unroll") for (int k = 0; k < 2; ++k) dst[n][k] = *(const LAS bf16x8*)(lds + PG8_SB(b, h) + boff + n * 2048 + k * 1024); } while (0)
#define PG8_MMA(ai, bj, At, Bt) do { __builtin_amdgcn_s_setprio(1); _Pragma("unroll") for (int m = 0; m < 4; ++m) _Pragma("unroll") for (int n = 0; n < 2; ++n) _Pragma("unroll") for (int k = 0; k < 2; ++k) \
        acc[ai][bj][m][n] = __builtin_amdgcn_mfma_f32_16x16x32_bf16(Bt[n][k], At[m][k], acc[ai][bj][m][n], 0, 0, 0); __builtin_amdgcn_s_setprio(0); } while (0)
#define PG8_WAIT_V(n) asm volatile("s_waitcnt vmcnt(" #n ")" ::: "memory")
#define PG8_WAIT_L(n) asm volatile("s_waitcnt lgkmcnt(" #n ")" ::: "memory")
#define PG8_BAR __builtin_amdgcn_s_barrier()
#define PG8_SCHED __builtin_amdgcn_sched_barrier(0)
    Unit cur, nxt; int ui = 0;
    if (!S.next(0, cur)) return;
    f32x4 acc[2][2][4][2];
#pragma unroll
    for (int a = 0; a < 2; ++a)
#pragma unroll
        for (int b = 0; b < 2; ++b)
#pragma unroll
            for (int m = 0; m < 4; ++m)
#pragma unroll
                for (int n = 0; n < 2; ++n) acc[a][b][m][n] = (f32x4){0.f, 0.f, 0.f, 0.f};
    bf16x8 At[4][2], B0[2][2], B1[2][2];
    const char* cA = (const char*)(cur.kind ? g.A1 : g.A0) + (size_t)cur.pm * tstep; const char* cB = (const char*)(cur.kind ? g.B1 : g.B0) + (size_t)cur.pn * tstep;
    if constexpr (SP2) {
        PG8_STAGE(PG8_SB(0, 0), cB, voffB); PG8_STAGE(PG8_SB(0, 1), cB + hstep, voffB); PG8_STAGE(PG8_SA(0, 0), cA, voffA); PG8_STAGE(PG8_SA(0, 1), cA + hstep, voffA);
        if (wr == 1) PG8_BAR;
        PG8_WAIT_V(2); PG8_BAR;
        PG8_STAGE(PG8_SB(1, 0), cB + kstep, voffB); PG8_STAGE(PG8_SA(1, 0), cA + kstep, voffA); PG8_STAGE(PG8_SB(1, 1), cB + hstep + kstep, voffB);
        PG8_WAIT_V(6); PG8_BAR;
    } else {
    PG8_STAGE(PG8_SB(0, 0), cB, voffB); PG8_STAGE(PG8_SA(0, 0), cA, voffA); PG8_STAGE(PG8_SB(0, 1), cB + hstep, voffB); PG8_STAGE(PG8_SA(0, 1), cA + hstep, voffA);
    if (wr == 1) PG8_BAR;
    PG8_WAIT_V(4); PG8_BAR;
    PG8_STAGE(PG8_SB(1, 0), cB + kstep, voffB); PG8_STAGE(PG8_SA(1, 0), cA + kstep, voffA); PG8_STAGE(PG8_SB(1, 1), cB + hstep + kstep, voffB);
    PG8_WAIT_V(6); PG8_BAR;
    }
    for (;;) {
        const bool has_next = S.next(ui + 1, nxt);
        const char* nA = has_next ? (const char*)(nxt.kind ? g.A1 : g.A0) + (size_t)nxt.pm * tstep : cA; const char* nB = has_next ? (const char*)(nxt.kind ? g.B1 : g.B0) + (size_t)nxt.pn * tstep : cB;
        for (int t = 0; t < nt; t += 2) {
            const bool last = (t == nt - 2);
            const char* a1 = cA + (size_t)(t + 1) * kstep;
            const char* a2 = last ? nA : cA + (size_t)(t + 2) * kstep; const char* b2 = last ? nB : cB + (size_t)(t + 2) * kstep;
            const char* a3 = a2 + kstep; const char* b3 = b2 + kstep;
            if constexpr (SP2) {
            PG8_LDB(B0, 0, 0); PG8_LDB(B1, 0, 1); PG8_SCHED; PG8_LDA(At, 0, 0); PG8_STAGE(PG8_SA(1, 1), a1 + hstep, voffA);
            PG8_WAIT_V(8); PG8_WAIT_L(0); PG8_BAR; PG8_MMA(0, 0, At, B0); PG8_MMA(0, 1, At, B1); PG8_BAR; PG8_SCHED;
            PG8_LDA(At, 0, 1); PG8_STAGE(PG8_SB(0, 0), b2, voffB); PG8_STAGE(PG8_SB(0, 1), b2 + hstep, voffB); PG8_STAGE(PG8_SA(0, 0), a2, voffA);
            PG8_WAIT_V(8); PG8_WAIT_L(0); PG8_BAR; PG8_MMA(1, 0, At, B0); PG8_MMA(1, 1, At, B1); PG8_BAR; PG8_SCHED;
            PG8_LDB(B0, 1, 0); PG8_LDB(B1, 1, 1); PG8_SCHED; PG8_LDA(At, 1, 0); PG8_STAGE(PG8_SA(0, 1), a2 + hstep, voffA);
            PG8_WAIT_V(8); PG8_WAIT_L(0); PG8_BAR; PG8_MMA(0, 0, At, B0); PG8_MMA(0, 1, At, B1); PG8_BAR; PG8_SCHED;
            PG8_LDA(At, 1, 1); PG8_STAGE(PG8_SB(1, 0), b3, voffB); PG8_STAGE(PG8_SB(1, 1), b3 + hstep, voffB); PG8_STAGE(PG8_SA(1, 0), a3, voffA);
            PG8_WAIT_V(8); PG8_WAIT_L(0); PG8_BAR; PG8_MMA(1, 0, At, B0); PG8_MMA(1, 1, At, B1); PG8_BAR; PG8_SCHED;
            } else {
            PG8_LDB(B0, 0, 0); PG8_SCHED; PG8_LDA(At, 0, 0); PG8_STAGE(PG8_SA(1, 1), a1 + hstep, voffA);
            PG8_WAIT_L(8); PG8_BAR; PG8_WAIT_L(0); PG8_MMA(0, 0, At, B0); PG8_BAR; PG8_SCHED;
            PG8_LDB(B1, 0, 1); PG8_STAGE(PG8_SB(0, 0), b2, voffB);
            PG8_BAR; PG8_WAIT_L(0); PG8_MMA(0, 1, At, B1); PG8_BAR;
            PG8_LDA(At, 0, 1); PG8_STAGE(PG8_SA(0, 0), a2, voffA);
            PG8_BAR; PG8_WAIT_L(0); PG8_MMA(1, 0, At, B0); PG8_BAR; PG8_SCHED;
            PG8_STAGE(PG8_SB(0, 1), b2 + hstep, voffB);
            PG8_WAIT_V(6); PG8_BAR; PG8_MMA(1, 1, At, B1); PG8_BAR;
            PG8_LDB(B0, 1, 0); PG8_SCHED; PG8_LDA(At, 1, 0); PG8_STAGE(PG8_SA(0, 1), a2 + hstep, voffA);
            PG8_WAIT_L(8); PG8_BAR; PG8_WAIT_L(0); PG8_MMA(0, 0, At, B0); PG8_BAR; PG8_SCHED;
            PG8_LDB(B1, 1, 1); PG8_STAGE(PG8_SB(1, 0), b3, voffB);
            PG8_BAR; PG8_WAIT_L(0); PG8_MMA(0, 1, At, B1); PG8_BAR;
            PG8_LDA(At, 1, 1); PG8_STAGE(PG8_SA(1, 0), a3, voffA);
            PG8_BAR; PG8_WAIT_L(0); PG8_MMA(1, 0, At, B0); PG8_BAR; PG8_SCHED;
            PG8_STAGE(PG8_SB(1, 1), b3 + hstep, voffB);
            PG8_WAIT_V(6); PG8_BAR; PG8_MMA(1, 1, At, B1); PG8_BAR;
            }
        }
        if constexpr (ALIGN_EPI) { if (wr == 0) PG8_BAR; }
        const bool keep = E(acc, cur, wr, wc, fr, fq);
        if (!has_next) break;
        if (!keep) {
#pragma unroll
        for (int a = 0; a < 2; ++a)
#pragma unroll
            for (int b = 0; b < 2; ++b)
#pragma unroll
                for (int m = 0; m < 4; ++m)
#pragma unroll
                    for (int n = 0; n < 2; ++n) acc[a][b][m][n] = (f32x4){0.f, 0.f, 0.f, 0.f};
        }
        cur = nxt; cA = nA; cB = nB; ++ui;
        if constexpr (ALIGN_EPI) { if (wr == 1) PG8_BAR; }
    }
    PG8_WAIT_V(0);
    if constexpr (!ALIGN_EPI) { if (wr == 0) PG8_BAR; }
    PG8_BAR;
#undef PG8_SA
#undef PG8_SB
#undef PG8_STAGE
#undef PG8_LDA
#undef PG8_LDB
#undef PG8_MMA
#undef PG8_WAIT_V
#undef PG8_WAIT_L
#undef PG8_BAR
#undef PG8_SCHED
}
}

typedef unsigned long long ssq_t;
constexpr float SSQ_SCALE = 16777216.0f;
__device__ __forceinline__ ssq_t ssq_fix(float s) { return (ssq_t)(s * SSQ_SCALE + 0.5f); }
__device__ __forceinline__ float row_rstd(const ssq_t* ss, int row) { return rsqrtf((float)ss[row] * (1.0f / SSQ_SCALE) * (1.0f / D) + EPS); }

struct EpiGU {
    static constexpr bool PERM = true;
    const ssq_t* ss; bf16_t* act;
    __device__ __forceinline__ bool operator()(f32x4 (&acc)[2][2][4][2], const pg8::Unit& u, int wr, int wc, int fr, int fq) const {
        const int row0 = u.pm * 256 + wr * 64 + fr, col0 = u.pn * 128 + wc * 32 + 8 * fq;
#pragma unroll
        for (int ai = 0; ai < 2; ++ai)
#pragma unroll
            for (int m = 0; m < 4; ++m) {
                const int row = row0 + ai * 128 + m * 16; const float r = row_rstd(ss, row);
                float o[8];
#pragma unroll
                for (int n = 0; n < 2; ++n)
#pragma unroll
                    for (int j = 0; j < 4; ++j) { const float gv = acc[ai][0][m][n][j] * r, uv = acc[ai][1][m][n][j] * r; o[n * 4 + j] = gv * sigmoidf_(gv) * uv; }
                u32x4 w; w.x = pk2(o[0], o[1]); w.y = pk2(o[2], o[3]); w.z = pk2(o[4], o[5]); w.w = pk2(o[6], o[7]);
                *(u32x4*)(act + (size_t)row * FF + col0) = w;
            }
        return false;
    }
};
struct EpiRes {
    static constexpr bool PERM = false;
    const float* xin32; bf16_t* xb; ssq_t* ss_out; float scale;
    __device__ __forceinline__ bool operator()(f32x4 (&acc)[2][2][4][2], const pg8::Unit& u, int wr, int wc, int fr, int fq) const {
        const int row0 = u.pm * 256 + wr * 64 + fr, col0 = u.pn * 256 + wc * 32 + 4 * fq;
#pragma unroll
        for (int ai = 0; ai < 2; ++ai)
#pragma unroll
            for (int m = 0; m < 4; ++m) {
                const int row = row0 + ai * 128 + m * 16; float s = 0.f;
#pragma unroll
                for (int bj = 0; bj < 2; ++bj)
#pragma unroll
                    for (int n = 0; n < 2; ++n) {
                        const size_t off = (size_t)row * D + col0 + bj * 128 + n * 16;
                        f32x4 xv;
                        if (xin32) xv = __builtin_nontemporal_load((const f32x4*)(xin32 + off));
                        else { const u32x2 wi = *(const u32x2*)(xb + off); xv = (f32x4){bf_lo(wi.x), bf_hi(wi.x), bf_lo(wi.y), bf_hi(wi.y)}; }
                        xv = xv + acc[ai][bj][m][n] * scale;
                        u32x2 w; w.x = pk2(xv[0], xv[1]); w.y = pk2(xv[2], xv[3]); *(u32x2*)(xb + off) = w;
                        const float r0 = bf_lo(w.x), r1 = bf_hi(w.x), r2 = bf_lo(w.y), r3 = bf_hi(w.y);
                        s += (r0 * r0 + r1 * r1) + (r2 * r2 + r3 * r3);
                    }
                s += __shfl_xor(s, 16); s += __shfl_xor(s, 32);
                if (fq == 0) __hip_atomic_fetch_add(ss_out + row, ssq_fix(s), __ATOMIC_RELAXED, __HIP_MEMORY_SCOPE_AGENT);
            }
        return false;
    }
};
struct EpiP {
    static constexpr bool PERM = true;
    const ssq_t* ss; bf16_t* P;
    __device__ __forceinline__ bool operator()(f32x4 (&acc)[2][2][4][2], const pg8::Unit& u, int wr, int wc, int fr, int fq) const {
        const int row0 = u.pm * 256 + wr * 64 + fr, col0 = u.pn * 256 + wc * 32 + 8 * fq;
#pragma unroll
        for (int ai = 0; ai < 2; ++ai)
#pragma unroll
            for (int m = 0; m < 4; ++m) {
                const int row = row0 + ai * 128 + m * 16; const float r = row_rstd(ss, row);
#pragma unroll
                for (int bj = 0; bj < 2; ++bj) {
                    const f32x4 v0 = acc[ai][bj][m][0] * r, v1 = acc[ai][bj][m][1] * r;
                    u32x4 w; w.x = pk2(v0[0], v0[1]); w.y = pk2(v0[2], v0[3]); w.z = pk2(v1[0], v1[1]); w.w = pk2(v1[2], v1[3]);
                    *(u32x4*)(P + (size_t)row * INC + col0 + bj * 128) = w;
                }
            }
        return false;
    }
};
struct EpiMerge {
    static constexpr bool PERM = true;
    const bf16_t* P; bf16_t* mg;
    __device__ __forceinline__ bool operator()(f32x4 (&acc)[2][2][4][2], const pg8::Unit& u, int wr, int wc, int fr, int fq) const {
        const int row0 = u.pm * 256 + wr * 64 + fr, col0 = u.pn * 256 + wc * 32 + 8 * fq;
#pragma unroll
        for (int ai = 0; ai < 2; ++ai)
#pragma unroll
            for (int m = 0; m < 4; ++m) {
                const int row = row0 + ai * 128 + m * 16;
#pragma unroll
                for (int bj = 0; bj < 2; ++bj) {
                    const int col = col0 + bj * 128;
                    const u32x4 gb = *(const u32x4*)(P + (size_t)row * INC + PC_GB + col);
                    if (u.kind == 0) {
                        const u32x4 ga = __builtin_nontemporal_load((const u32x4*)(P + (size_t)row * INC + PC_GA + col));
#pragma unroll
                        for (int q = 0; q < 4; ++q) {
                            const float a0 = bf_lo(ga[q]), a1 = bf_hi(ga[q]), b0 = bf_lo(gb[q]), b1 = bf_hi(gb[q]);
                            const float r0 = (1.0f + fexp(-b0)) * __builtin_amdgcn_rcpf(1.0f + fexp(-a0));
                            const float r1 = (1.0f + fexp(-b1)) * __builtin_amdgcn_rcpf(1.0f + fexp(-a1));
                            acc[ai][bj][m][q >> 1][(q & 1) * 2 + 0] *= r0; acc[ai][bj][m][q >> 1][(q & 1) * 2 + 1] *= r1;
                        }
                    } else {
                        float o[8];
#pragma unroll
                        for (int q = 0; q < 4; ++q) {
                            o[2 * q] = acc[ai][bj][m][q >> 1][(q & 1) * 2 + 0] * sigmoidf_(bf_lo(gb[q]));
                            o[2 * q + 1] = acc[ai][bj][m][q >> 1][(q & 1) * 2 + 1] * sigmoidf_(bf_hi(gb[q]));
                        }
                        u32x4 w; w.x = pk2(o[0], o[1]); w.y = pk2(o[2], o[3]); w.z = pk2(o[4], o[5]); w.w = pk2(o[6], o[7]);
                        *(u32x4*)(mg + (size_t)row * D + col) = w;
                    }
                }
            }
        return u.kind == 0;
    }
};

__device__ __forceinline__ void p0_item(const float* W, const float* gain, int K, int N, bf16_t* WT, int mode, LAS float* scr, int item, int lane) {
    const int nblk = N / 64, kb = item / nblk, nb = item % nblk, k0 = 64 * kb, n0 = 64 * nb;
    const int kr = lane >> 4, nc = (lane & 15) * 4;
    f32x4 v[16];
#pragma unroll
    for (int i = 0; i < 16; ++i) v[i] = __builtin_nontemporal_load((const f32x4*)(W + (size_t)(k0 + 4 * i + kr) * N + n0 + nc));
    if (gain) {
#pragma unroll
        for (int i = 0; i < 16; ++i) v[i] = v[i] * gain[k0 + 4 * i + kr];
    }
#pragma unroll
    for (int i = 0; i < 16; ++i) { LAS float* s = scr + (4 * i + kr) * 65 + nc; s[0] = v[i][0]; s[1] = v[i][1]; s[2] = v[i][2]; s[3] = v[i][3]; }
    LDS_WAIT();
    const int c = lane & 7;
    const int rbase = (mode == 0) ? n0 : ((n0 >> 7) * 256 + (mode == 2 ? 128 : 0) + (n0 & 127));
#pragma unroll
    for (int j = 0; j < 8; ++j) { const int n = (lane >> 3) + 8 * j; const LAS float* s = scr + (8 * c) * 65 + n;
        u32x4 o; o.x = pk2(s[0 * 65], s[1 * 65]); o.y = pk2(s[2 * 65], s[3 * 65]); o.z = pk2(s[4 * 65], s[5 * 65]); o.w = pk2(s[6 * 65], s[7 * 65]);
        *(u32x4*)(WT + (size_t)(rbase + n) * K + k0 + 8 * c) = o; }
    LDS_WAIT();
}

constexpr int I_FF = (D / 64) * (FF / 64), I_DN = (FF / 64) * (D / 64), I_IN = (D / 64) * (INC / 64), I_AB = (RGW / 64) * (D / 64), I_OUT = (D / 64) * (D / 64);
constexpr int I_A = 2 * I_FF + I_DN + I_IN;
constexpr int I_LAYER = 4 * I_FF + 2 * I_DN + I_IN + 2 * I_AB + I_OUT;
constexpr int I_P0 = 2 * I_FF;
constexpr int I_CUT2 = I_LAYER + 2 * I_FF;
__device__ __forceinline__ void convert_items(const Params& p, LAS unsigned char* lds, int lo, int hi, int wv, int nwv) {
    const int tid = opaque_tid(), lane = tid & 63, wave = tid >> 6;
    LAS float* scr = (LAS float*)(lds + wave * 16640);
    for (int it = lo + wv; it < hi; it += nwv) {
        const int l = it >= I_LAYER ? 1 : 0; int r = it - l * I_LAYER;
        bf16_t* wl = (bf16_t*)(p.ws + (size_t)l * SZ_LAYER);
        const float* W; const float* gain = nullptr; int K, N, mode = 0; size_t off;
        if (r < I_FF) { W = p.ffn1_wg + (size_t)l * D * FF; gain = p.ffn1_norm + l * D; K = D; N = FF; mode = 1; off = OFF_WGU1; }
        else if ((r -= I_FF) < I_FF) { W = p.ffn1_wu + (size_t)l * D * FF; gain = p.ffn1_norm + l * D; K = D; N = FF; mode = 2; off = OFF_WGU1; }
        else if ((r -= I_FF) < I_DN) { W = p.ffn1_wd + (size_t)l * D * FF; K = FF; N = D; off = OFF_WD1; }
        else if ((r -= I_DN) < I_IN) { W = p.w_in + (size_t)l * D * INC; gain = p.mix_norm + l * D; K = D; N = INC; off = OFF_WIN; }
        else if ((r -= I_IN) < I_AB) { W = p.wa + (size_t)l * RGW * D; K = RGW; N = D; off = OFF_WA; }
        else if ((r -= I_AB) < I_AB) { W = p.wb + (size_t)l * RGW * D; K = RGW; N = D; off = OFF_WB; }
        else if ((r -= I_AB) < I_OUT) { W = p.wout + (size_t)l * D * D; K = D; N = D; off = OFF_WOUT; }
        else if ((r -= I_OUT) < I_FF) { W = p.ffn2_wg + (size_t)l * D * FF; gain = p.ffn2_norm + l * D; K = D; N = FF; mode = 1; off = OFF_WGU2; }
        else if ((r -= I_FF) < I_FF) { W = p.ffn2_wu + (size_t)l * D * FF; gain = p.ffn2_norm + l * D; K = D; N = FF; mode = 2; off = OFF_WGU2; }
        else { r -= I_FF; W = p.ffn2_wd + (size_t)l * D * FF; K = FF; N = D; off = OFF_WD2; }
        p0_item(W, gain, K, N, (bf16_t*)((unsigned char*)wl + off), mode, scr, r, lane);
    }
}
__device__ __forceinline__ void tail_convert(const Params& p, LAS unsigned char* lds, int nunits, int G, int c, int lo, int hi) {
    const int rem = nunits % G, wave = opaque_tid() >> 6;
    if (rem != 0 && c < rem) return;
    convert_items(p, lds, lo, hi, (c - rem) * NWAVES + wave, (G - rem) * NWAVES);
}

__device__ __forceinline__ void p0_prologue(const Params& p, LAS unsigned char* lds, int G) {
    const int tid = opaque_tid(), lane = tid & 63, wave = tid >> 6;
    const int gw = blockIdx.x * NWAVES + wave, NGW = G * NWAVES;
    convert_items(p, lds, 0, I_P0, gw, NGW);
    ssq_t* ss = (ssq_t*)(p.ws + WS_SS); bf16_t* xb = (bf16_t*)(p.ws + WS_XB);
    for (int row = gw; row < T; row += NGW) {
        const f32x4* xr = (const f32x4*)(p.x + (size_t)row * D) + lane; u32x2* o = (u32x2*)(xb + (size_t)row * D) + lane; float s = 0.f;
#pragma unroll
        for (int j = 0; j < 8; ++j) { const f32x4 v = __builtin_nontemporal_load(xr + 64 * j); s += (v[0] * v[0] + v[1] * v[1]) + (v[2] * v[2] + v[3] * v[3]); u32x2 w; w.x = pk2(v[0], v[1]); w.y = pk2(v[2], v[3]); o[64 * j] = w; }
        s = wave_sum(s); if (lane == 0) ss[row] = ssq_fix(s);
    }
    for (int i = blockIdx.x * NTHREADS + tid; i < 7 * T; i += G * NTHREADS) ss[T + i] = 0ull;
}

constexpr int H_QS = 272, H_TS = 144;
constexpr int HB_SZ = 62464, HB_QI = 0, HB_KI = 17408, HB_KIT = 34816, HB_VT = 53248;
constexpr int H_ST = 2 * HB_SZ, H_PM = H_ST + 17408, H_GT = H_PM + 9216;
static_assert(H_GT + 2 * 2048 <= LDS_BAR_OFF, "HGRN LDS image");
__device__ __forceinline__ void hgrn_chain(const Params& p, LAS unsigned char* lds, int layer, int chain, int dvh) {
    const int tid = opaque_tid(), lane = tid & 63, wave = __builtin_amdgcn_readfirstlane(tid >> 6), fr = lane & 15, fq = lane >> 4;
    const bf16_t* P = (const bf16_t*)(p.ws + WS_P);
    const int b = chain >> 4, h = (chain >> 1) & 7, dir = chain & 1;
    float* O = (float*)(p.ws + (dir ? WS_OB : WS_OF));
    const float* lbl = dir ? p.lbb : p.lbf;
    const int zc = (dir ? PC_ZB : PC_ZF) + h * 128;
    const int d = tid & 127, tg = tid >> 7;
    const int vs = tid & 63, vg = tid >> 6;
    float lb = 0.f;
    if (layer == 1) { const int ch = h * 128 + d; lb = sigmoidf_(lbl[RGW + ch] - lbl[ch]); }
    f32x4 Sacc[4];
#pragma unroll
    for (int i = 0; i < 4; ++i) Sacc[i] = (f32x4){0.f, 0.f, 0.f, 0.f};
    bf16_t zr[16], qr[16]; u32x4 vr0;
    float pb[16], kk_[16], qf[16]; u32x4 v0;
    const ptrdiff_t tstep_ = dir ? -(ptrdiff_t)INC : (ptrdiff_t)INC;
#define HG_TOK(c, j) ((size_t)b * SEQ + (dir ? ((SEQ / 64 - 1 - (c)) * 64 + 63 - (j)) : ((c) * 64 + (j))))
#define HG_LOAD(c) do { const bf16_t* zp_ = P + HG_TOK(c, tg * 16) * INC + zc + d; const bf16_t* qp_ = P + HG_TOK(c, tg * 16) * INC + PC_Q + h * 128 + d; \
        _Pragma("unroll") for (int i = 0; i < 16; ++i) { zr[i] = *zp_; qr[i] = *qp_; zp_ += tstep_; qp_ += tstep_; } \
        { const size_t tk = HG_TOK(c, vs); const bf16_t* vp = P + tk * INC + PC_I + h * 128 + dvh * 64 + vg * 8; vr0 = *(const u32x4*)vp; } } while (0)
#define HG_A1(g) do { LAS float* GT_ = (LAS float*)(lds + H_GT + (g) * 2048); float run = 1.f; \
        _Pragma("unroll") for (int i = 0; i < 16; ++i) { \
            const float z = fmaxf(bf1(zr[i]), -60.0f); const float e = fexp(-z), sg = __builtin_amdgcn_rcpf(1.0f + e); \
            const float f = lb + (1.0f - lb) * sg; kk_[i] = (1.0f - lb) * e * sg; run *= f; pb[i] = run; qf[i] = bf1(qr[i]); } \
        GT_[tg * 128 + d] = run; v0 = vr0; } while (0)
#define HG_A2(g, lb_) do { const LAS float* GT_ = (const LAS float*)(lds + H_GT + (g) * 2048); \
        const float g0 = GT_[d], g1 = GT_[128 + d], g2 = GT_[256 + d]; \
        const float den = (tg == 0) ? g0 * g1 : g1; \
        const float C = (tg >= 2) ? (tg == 3 ? g2 : 1.0f) : __builtin_amdgcn_rcpf(fmaxf(den, 1e-36f)); \
        unsigned kw[8]; \
        _Pragma("unroll") for (int i = 0; i < 16; i += 2) { \
            const float eq0 = fminf(fmaxf(pb[i] * C, 2.4e-35f), 4.15e34f), eq1 = fminf(fmaxf(pb[i + 1] * C, 2.4e-35f), 4.15e34f); \
            const float ek0 = __builtin_amdgcn_rcpf(eq0), ek1 = __builtin_amdgcn_rcpf(eq1); \
            const unsigned qw = pk2(qf[i] * eq0, qf[i + 1] * eq1); kw[i >> 1] = pk2(kk_[i] * ek0, kk_[i + 1] * ek1); \
            const int j = tg * 16 + i; \
            *(LAS bf16_t*)((lb_) + HB_QI + j * H_QS + d * 2) = (bf16_t)(qw & 0xffffu); *(LAS bf16_t*)((lb_) + HB_QI + (j + 1) * H_QS + d * 2) = (bf16_t)(qw >> 16); \
            *(LAS bf16_t*)((lb_) + HB_KI + j * H_QS + d * 2) = (bf16_t)(kw[i >> 1] & 0xffffu); *(LAS bf16_t*)((lb_) + HB_KI + (j + 1) * H_QS + d * 2) = (bf16_t)(kw[i >> 1] >> 16); } \
        u32x4 w0, w1; w0.x = kw[0]; w0.y = kw[1]; w0.z = kw[2]; w0.w = kw[3]; w1.x = kw[4]; w1.y = kw[5]; w1.z = kw[6]; w1.w = kw[7]; \
        *(LAS u32x4*)((lb_) + HB_KIT + d * H_TS + tg * 32) = w0; *(LAS u32x4*)((lb_) + HB_KIT + d * H_TS + tg * 32 + 16) = w1; \
        _Pragma("unroll") for (int q = 0; q < 4; ++q) { \
            *(LAS bf16_t*)((lb_) + HB_VT + (vg * 8 + 2 * q) * H_TS + vs * 2) = (bf16_t)(v0[q] & 0xffffu); *(LAS bf16_t*)((lb_) + HB_VT + (vg * 8 + 2 * q + 1) * H_TS + vs * 2) = (bf16_t)(v0[q] >> 16); } } while (0)
    HG_LOAD(0);
    HG_A1(0);
    HG_LOAD(1);
    LDS_BARRIER();
    HG_A2(0, lds);
    LDS_BARRIER();
    for (int c = 0; c < SEQ / 64; ++c) {
        const int cur = c & 1;
        LAS unsigned char* lc = lds + cur * HB_SZ;
        LAS unsigned char* ln = lds + (cur ^ 1) * HB_SZ;
        f32x4 eb, ec;
        {
            const LAS float* GT = (const LAS float*)(lds + H_GT + cur * 2048);
            const f32x4 g0 = *(const LAS f32x4*)(GT + wave * 16 + fq * 4), g1 = *(const LAS f32x4*)(GT + 128 + wave * 16 + fq * 4);
            const f32x4 g2 = *(const LAS f32x4*)(GT + 256 + wave * 16 + fq * 4), g3 = *(const LAS f32x4*)(GT + 384 + wave * 16 + fq * 4);
            eb = g0 * g1; ec = g2 * g3;
        }
#pragma unroll
        for (int dvt = 0; dvt < 4; ++dvt) {
            Sacc[dvt] = Sacc[dvt] * eb;
            u32x2 w; w.x = pk2(Sacc[dvt][0], Sacc[dvt][1]); w.y = pk2(Sacc[dvt][2], Sacc[dvt][3]);
            *(LAS u32x2*)(lds + H_ST + (dvt * 16 + fr) * H_QS + (wave * 16 + fq * 4) * 2) = w;
        }
        {
            const int tt = wave >> 1;
#pragma unroll
            for (int u = 0; u < 2; ++u) {
                const int st = (wave & 1) * 2 + u;
                f32x4 a4 = (f32x4){0.f, 0.f, 0.f, 0.f};
                if (st <= tt) {
#pragma unroll
                    for (int kk = 0; kk < 4; ++kk) {
                        const bf16x8 ka = *(const LAS bf16x8*)(lc + HB_KI + (st * 16 + fr) * H_QS + (kk * 32 + fq * 8) * 2);
                        const bf16x8 qb = *(const LAS bf16x8*)(lc + HB_QI + (tt * 16 + fr) * H_QS + (kk * 32 + fq * 8) * 2);
                        a4 = __builtin_amdgcn_mfma_f32_16x16x32_bf16(ka, qb, a4, 0, 0, 0);
                    }
                    const int t = tt * 16 + fr;
#pragma unroll
                    for (int j = 0; j < 4; ++j) { const int s = st * 16 + fq * 4 + j; a4[j] = (s <= t) ? a4[j] : 0.f; }
                }
                u32x2 w; w.x = pk2(a4[0], a4[1]); w.y = pk2(a4[2], a4[3]);
                *(LAS u32x2*)(lds + H_PM + (tt * 16 + fr) * H_TS + (st * 16 + fq * 4) * 2) = w;
            }
        }
        if (c + 1 < SEQ / 64) { HG_A1(cur ^ 1); if (c + 2 < SEQ / 64) HG_LOAD(c + 2); }
        LDS_BARRIER();
        {
            const int dvt = wave & 3;
            bf16x8 va[2], sa[4];
#pragma unroll
            for (int ks = 0; ks < 2; ++ks) va[ks] = *(const LAS bf16x8*)(lc + HB_VT + (dvt * 16 + fr) * H_TS + (ks * 32 + fq * 8) * 2);
#pragma unroll
            for (int kk = 0; kk < 4; ++kk) sa[kk] = *(const LAS bf16x8*)(lds + H_ST + (dvt * 16 + fr) * H_QS + (kk * 32 + fq * 8) * 2);
#pragma unroll
            for (int u = 0; u < 2; ++u) {
                const int tt = (wave >> 2) * 2 + u;
                f32x4 o4 = (f32x4){0.f, 0.f, 0.f, 0.f};
#pragma unroll
                for (int ks = 0; ks < 2; ++ks) { const bf16x8 pbf = *(const LAS bf16x8*)(lds + H_PM + (tt * 16 + fr) * H_TS + (ks * 32 + fq * 8) * 2); o4 = __builtin_amdgcn_mfma_f32_16x16x32_bf16(va[ks], pbf, o4, 0, 0, 0); }
#pragma unroll
                for (int kk = 0; kk < 4; ++kk) { const bf16x8 qb = *(const LAS bf16x8*)(lc + HB_QI + (tt * 16 + fr) * H_QS + (kk * 32 + fq * 8) * 2); o4 = __builtin_amdgcn_mfma_f32_16x16x32_bf16(sa[kk], qb, o4, 0, 0, 0); }
                *(f32x4*)(O + HG_TOK(c, tt * 16 + fr) * RGW + h * 128 + dvh * 64 + dvt * 16 + fq * 4) = o4;
            }
        }
        {
            bf16x8 ka[2];
#pragma unroll
            for (int ks = 0; ks < 2; ++ks) ka[ks] = *(const LAS bf16x8*)(lc + HB_KIT + (wave * 16 + fr) * H_TS + (ks * 32 + fq * 8) * 2);
#pragma unroll
            for (int dvt = 0; dvt < 4; ++dvt) {
#pragma unroll
                for (int ks = 0; ks < 2; ++ks) { const bf16x8 vb = *(const LAS bf16x8*)(lc + HB_VT + (dvt * 16 + fr) * H_TS + (ks * 32 + fq * 8) * 2); Sacc[dvt] = __builtin_amdgcn_mfma_f32_16x16x32_bf16(ka[ks], vb, Sacc[dvt], 0, 0, 0); }
                Sacc[dvt] = Sacc[dvt] * ec;
            }
        }
        if (c + 1 < SEQ / 64) HG_A2(cur ^ 1, ln);
        LDS_BARRIER();
    }
    __syncthreads();
#undef HG_A1
#undef HG_A2
#undef HG_LOAD
#undef HG_TOK
}

__device__ __forceinline__ void post_phase(const Params& p, int G, int layer) {
    const int tid = opaque_tid(), lane = tid & 63, wave = tid >> 6;
    const bf16_t* P = (const bf16_t*)(p.ws + WS_P); const float* OF = (const float*)(p.ws + WS_OF); const float* OB = (const float*)(p.ws + WS_OB);
    bf16_t* OA = (bf16_t*)(p.ws + WS_OA); const float* gain = p.rg_norm + layer * RGW;
    for (int pr = blockIdx.x * NWAVES + wave; pr < T * 8; pr += G * NWAVES) {
        const int tok = pr >> 3, h = pr & 7; const size_t off = (size_t)tok * RGW + h * 128 + 2 * lane;
        const f32x2 a = __builtin_nontemporal_load((const f32x2*)(OF + off)), bq = __builtin_nontemporal_load((const f32x2*)(OB + off));
        const float o0 = a[0] + bq[0], o1 = a[1] + bq[1];
        const float s = wave_sum(o0 * o0 + o1 * o1); const float r = rsqrtf(s * (1.0f / 128.0f) + EPS);
        const unsigned gw_ = __builtin_nontemporal_load((const unsigned*)(P + (size_t)tok * INC + PC_G + h * 128 + 2 * lane));
        const float g0 = bf_lo(gw_), g1 = bf_hi(gw_);
        const f32x2 gn = *(const f32x2*)(gain + h * 128 + 2 * lane);
        *(unsigned*)(OA + off) = pk2(o0 * r * gn[0] * (g0 * sigmoidf_(g0)), o1 * r * gn[1] * (g1 * sigmoidf_(g1)));
    }
}

constexpr int KST = 272;
constexpr int VST = 136;
__device__ __forceinline__ void attn_phase(const Params& p, LAS unsigned char* lds, int first, int stride, int layer) {
    const int tid = opaque_tid(), lane = tid & 63, wave = tid >> 6, fr = lane & 15, fq = lane >> 4;
    const bf16_t* P = (const bf16_t*)(p.ws + WS_P); bf16_t* OT = (bf16_t*)(p.ws + WS_OT);
    LAS unsigned char* Kt = lds;
    LAS unsigned char* Vt = lds + 64 * KST;
    for (int item = first; item < 4 * 16 * 8; item += stride) {
        const int h = item & 7, qb = (item >> 3) & 15, b = item >> 7, kvh = h >> 2;
        const float slope = exp2f(-(float)(h + 1)), sinkv = p.sink[layer * 8 + h];
        const int q0 = qb * 128, qw = q0 + wave * 16, qt = qw + fr;
        const size_t tokq = (size_t)b * SEQ + qt;
        bf16x8 Qf[4];
#pragma unroll
        for (int kk = 0; kk < 4; ++kk) Qf[kk] = *(const bf16x8*)(P + tokq * INC + PC_AQ + h * 128 + kk * 32 + fq * 8);
        f32x4 Oa[8];
#pragma unroll
        for (int i = 0; i < 8; ++i) Oa[i] = (f32x4){0.f, 0.f, 0.f, 0.f};
        float mrun = sinkv, lrun = 1.0f;
        const int kb_lo = (q0 - 128 < 0) ? 2 : 0, kb_hi = (q0 + 256 > SEQ) ? 4 : 6;
        const int skey = tid >> 4, sd0 = (tid & 15) * 8;
        u32x4 kreg[2], vreg[2];
#define AT_LOAD(kb_) do { const int k0_ = q0 - 128 + (kb_) * 64; _Pragma("unroll") for (int i = 0; i < 2; ++i) { const size_t tk = (size_t)b * SEQ + k0_ + skey + i * 32; \
            kreg[i] = *(const u32x4*)(P + tk * INC + PC_AK + kvh * 128 + sd0); vreg[i] = *(const u32x4*)(P + tk * INC + PC_AV + kvh * 128 + sd0); } } while (0)
        AT_LOAD(kb_lo);
        for (int kb = kb_lo; kb < kb_hi; ++kb) {
            const int k0 = q0 - 128 + kb * 64;
            __syncthreads();
#pragma unroll
            for (int i = 0; i < 2; ++i) {
                const int key = skey + i * 32;
                *(LAS u32x4*)(Kt + key * KST + sd0 * 2) = kreg[i];
#pragma unroll
                for (int q = 0; q < 4; ++q) {
                    *(LAS bf16_t*)(Vt + (sd0 + 2 * q) * VST + key * 2) = (bf16_t)(vreg[i][q] & 0xffffu);
                    *(LAS bf16_t*)(Vt + (sd0 + 2 * q + 1) * VST + key * 2) = (bf16_t)(vreg[i][q] >> 16);
                }
            }
            __syncthreads();
            if (kb + 1 < kb_hi) AT_LOAD(kb + 1);
            if (k0 + 63 < qw - 128 || k0 > qw + 15 + 128) continue;
            f32x4 Sa[4];
#pragma unroll
            for (int t = 0; t < 4; ++t) {
                Sa[t] = (f32x4){0.f, 0.f, 0.f, 0.f};
#pragma unroll
                for (int kk = 0; kk < 4; ++kk) {
                    const bf16x8 kf = *(const LAS bf16x8*)(Kt + (t * 16 + fr) * KST + (kk * 32 + fq * 8) * 2);
                    Sa[t] = __builtin_amdgcn_mfma_f32_16x16x32_bf16(kf, Qf[kk], Sa[t], 0, 0, 0);
                }
            }
            float mloc = -INFINITY;
#pragma unroll
            for (int t = 0; t < 4; ++t)
#pragma unroll
                for (int j = 0; j < 4; ++j) {
                    const int kt = k0 + t * 16 + fq * 4 + j; const int rel = kt - qt; const int ar = rel < 0 ? -rel : rel;
                    float s = Sa[t][j] * 0.08838834764831845f - slope * (float)ar;
                    s = (ar <= 128) ? s : -INFINITY;
                    Sa[t][j] = s; mloc = fmaxf(mloc, s);
                }
            mloc = fmaxf(mloc, __shfl_xor(mloc, 16)); mloc = fmaxf(mloc, __shfl_xor(mloc, 32));
            const float mnew = fmaxf(mrun, mloc), alpha = fexp(mrun - mnew);
            float lsum = 0.f;
#pragma unroll
            for (int t = 0; t < 4; ++t)
#pragma unroll
                for (int j = 0; j < 4; ++j) { const float e = fexp(Sa[t][j] - mnew); Sa[t][j] = e; lsum += e; }
            lsum += __shfl_xor(lsum, 16); lsum += __shfl_xor(lsum, 32);
            lrun = lrun * alpha + lsum; mrun = mnew;
#pragma unroll
            for (int i = 0; i < 8; ++i) Oa[i] = Oa[i] * alpha;
            bf16x8 Pf[2];
#pragma unroll
            for (int s2 = 0; s2 < 2; ++s2) {
                u32x4 w; w.x = pk2(Sa[2 * s2][0], Sa[2 * s2][1]); w.y = pk2(Sa[2 * s2][2], Sa[2 * s2][3]); w.z = pk2(Sa[2 * s2 + 1][0], Sa[2 * s2 + 1][1]); w.w = pk2(Sa[2 * s2 + 1][2], Sa[2 * s2 + 1][3]);
                Pf[s2] = __builtin_bit_cast(bf16x8, w);
            }
#pragma unroll
            for (int dt = 0; dt < 8; ++dt)
#pragma unroll
                for (int s2 = 0; s2 < 2; ++s2) {
                    const LAS unsigned char* vp = Vt + (dt * 16 + fr) * VST + (s2 * 32 + fq * 4) * 2;
                    const u32x2 lo = *(const LAS u32x2*)vp, hi = *(const LAS u32x2*)(vp + 32);
                    u32x4 w; w.x = lo.x; w.y = lo.y; w.z = hi.x; w.w = hi.y;
                    Oa[dt] = __builtin_amdgcn_mfma_f32_16x16x32_bf16(__builtin_bit_cast(bf16x8, w), Pf[s2], Oa[dt], 0, 0, 0);
                }
        }
        const float inv = 1.0f / lrun;
#pragma unroll
        for (int dt = 0; dt < 8; ++dt) {
            u32x2 w; w.x = pk2(Oa[dt][0] * inv, Oa[dt][1] * inv); w.y = pk2(Oa[dt][2] * inv, Oa[dt][3] * inv);
            *(u32x2*)(OT + tokq * RGW + h * 128 + dt * 16 + fq * 4) = w;
        }
    }
}

__device__ __forceinline__ void final_phase(const Params& p, int G) {
    const int tid = opaque_tid(), lane = tid & 63, wave = tid >> 6;
    const bf16_t* XBp = (const bf16_t*)(p.ws + WS_XB); const ssq_t* ss = (const ssq_t*)(p.ws + WS_SS) + 6 * T;
    for (int row = blockIdx.x * NWAVES + wave; row < T; row += G * NWAVES) {
        const float r = row_rstd(ss, row);
        const u32x2* xr = (const u32x2*)(XBp + (size_t)row * D) + lane; const f32x4* gr = (const f32x4*)p.final_norm + lane; f32x4* o = (f32x4*)(p.out + (size_t)row * D) + lane;
#pragma unroll
        for (int j = 0; j < 8; ++j) { const u32x2 w = __builtin_nontemporal_load(xr + 64 * j); const f32x4 xv = (f32x4){bf_lo(w.x), bf_hi(w.x), bf_lo(w.y), bf_hi(w.y)}; __builtin_nontemporal_store(xv * r * gr[64 * j], o + 64 * j); }
    }
}

__global__ void __launch_bounds__(NTHREADS, 2) fwd_megakernel(Params p) {
    extern __shared__ __attribute__((aligned(16))) unsigned char lds_raw[];
    LAS unsigned char* lds = (LAS unsigned char*)lds_raw;
    cg::grid_group grid = cg::this_grid();
    if (threadIdx.x < 4) ((LAS unsigned*)(lds + LDS_BAR_OFF))[threadIdx.x] = 0u;
    __syncthreads();
    XcdBarrier xbar = xcd_barrier_post((unsigned*)(p.ws + WS_BAR), (volatile LAS unsigned*)(lds + LDS_BAR_OFF));
    if (p.ws == nullptr) grid.sync();
#define GSYNC() xcd_barrier(xbar)
    const int G = gridDim.x, c = blockIdx.x;
    unsigned char* ws = p.ws;
    float* X = (float*)(ws + WS_X); bf16_t* XB = (bf16_t*)(ws + WS_XB); ssq_t* SS = (ssq_t*)(ws + WS_SS);
    bf16_t* ACT = (bf16_t*)(ws + WS_ACT); bf16_t* Pb = (bf16_t*)(ws + WS_P);
    bf16_t* OA = (bf16_t*)(ws + WS_OA); bf16_t* OT = (bf16_t*)(ws + WS_OT); bf16_t* MG = (bf16_t*)(ws + WS_MG);

#ifndef PHMASK
#define PHMASK 0xffff
#endif
#define PH(n) ((PHMASK >> (n)) & 1)
#if PH(0)
    p0_prologue(p, lds, G);
#endif
    GSYNC();
#pragma unroll 1
    for (int l = 0; l < 2; ++l) {
        const unsigned char* wl = ws + (size_t)l * SZ_LAYER;
        const ssq_t* ss_ffn1 = SS + (3 * l + 0) * T; ssq_t* ss_mix = SS + (3 * l + 1) * T; ssq_t* ss_ffn2 = SS + (3 * l + 2) * T; ssq_t* ss_next = SS + (3 * l + 3) * T;
#if PH(1)
        { pg8::Gemm g{XB, (const bf16_t*)(wl + OFF_WGU1), XB, (const bf16_t*)(wl + OFF_WGU1), T, 2 * FF, D}; pg8::StaticOrder S; S.init(T, 2 * FF, G, c);
          EpiGU E{ss_ffn1, ACT}; pg8::gemm_phase(lds, g, S, E); }
        if (l == 0) tail_convert(p, lds, (T / 256) * (2 * FF / 256), G, c, I_P0, I_A);
#endif
        GSYNC();
#if PH(2)
        { pg8::Gemm g{ACT, (const bf16_t*)(wl + OFF_WD1), ACT, (const bf16_t*)(wl + OFF_WD1), T, D, FF}; pg8::StaticOrder S; S.init(T, D, G, c);
          EpiRes E{l == 0 ? p.x : nullptr, XB, ss_mix, 0.5f}; pg8::gemm_phase(lds, g, S, E); }
#endif
        GSYNC();
#if PH(3)
        { pg8::Gemm g{XB, (const bf16_t*)(wl + OFF_WIN), XB, (const bf16_t*)(wl + OFF_WIN), T, INC, D}; pg8::StaticOrder S; S.init(T, INC, G, c);
          EpiP E{ss_mix, Pb}; pg8::gemm_phase(lds, g, S, E); }
        tail_convert(p, lds, (T / 256) * (INC / 256), G, c, l * I_LAYER + I_A, (l + 1) * I_LAYER);
#endif
        GSYNC();
#if PH(4)
        { const int hw = (G >= 256) ? 128 : 0;
          if (hw == 0 || c < hw) for (int ch = c; ch < 128; ch += (hw ? 128 : G)) hgrn_chain(p, lds, l, ch >> 1, ch & 1);
          if (c >= hw) { attn_phase(p, lds, c - hw, G - hw, l); __syncthreads(); if (l == 0) convert_items(p, lds, I_LAYER, I_CUT2, (c - hw) * NWAVES + (opaque_tid() >> 6), (G - hw) * NWAVES); } }
#endif
        GSYNC();
#if PH(6)
        post_phase(p, G, l);
#endif
        GSYNC();
#if PH(7)
        { pg8::Gemm g{OA, (const bf16_t*)(wl + OFF_WA), OT, (const bf16_t*)(wl + OFF_WB), T, D, RGW}; pg8::PairOrder S; S.init(T, D, G, c);
          EpiMerge E{Pb, MG}; pg8::gemm_phase(lds, g, S, E); }
#endif
        GSYNC();
#if PH(8)
        { pg8::Gemm g{MG, (const bf16_t*)(wl + OFF_WOUT), MG, (const bf16_t*)(wl + OFF_WOUT), T, D, D}; pg8::StaticOrder S; S.init(T, D, G, c);
          EpiRes E{nullptr, XB, ss_ffn2, 1.0f}; pg8::gemm_phase(lds, g, S, E); }
#endif
        GSYNC();
#if PH(9)
        { pg8::Gemm g{XB, (const bf16_t*)(wl + OFF_WGU2), XB, (const bf16_t*)(wl + OFF_WGU2), T, 2 * FF, D}; pg8::StaticOrder S; S.init(T, 2 * FF, G, c);
          EpiGU E{ss_ffn2, ACT}; pg8::gemm_phase(lds, g, S, E); }
        if (l == 0) tail_convert(p, lds, (T / 256) * (2 * FF / 256), G, c, I_CUT2, I_LAYER + I_A);
#endif
        GSYNC();
#if PH(10)
        { pg8::Gemm g{ACT, (const bf16_t*)(wl + OFF_WD2), ACT, (const bf16_t*)(wl + OFF_WD2), T, D, FF}; pg8::StaticOrder S; S.init(T, D, G, c);
          EpiRes E{nullptr, XB, ss_next, 0.5f}; pg8::gemm_phase(lds, g, S, E); }
#endif
        GSYNC();
    }
#if PH(11)
    final_phase(p, G);
#endif
}

extern "C" void kernel_launch(void* const* d_in, const int* in_sizes, int n_in, void* d_out, int out_size, void* d_ws, size_t ws_size, hipStream_t stream) {
    static int grid_blocks = 0;
    if (grid_blocks == 0) {
        if (n_in != 19 || ws_size < WS_END) { fprintf(stderr, "kernel_launch: unexpected n_in %d / ws_size %zu (need %zu)\n", n_in, ws_size, (size_t)WS_END); grid_blocks = -1; return; }
        int dev = 0, cus = 0, per_cu = 0;
        hipGetDevice(&dev);
        hipDeviceGetAttribute(&cus, hipDeviceAttributeMultiprocessorCount, dev);
        hipFuncSetAttribute((const void*)fwd_megakernel, hipFuncAttributeMaxDynamicSharedMemorySize, LDS_BYTES);
        hipOccupancyMaxActiveBlocksPerMultiprocessor(&per_cu, (const void*)fwd_megakernel, NTHREADS, LDS_BYTES);
        if (per_cu < 1) { fprintf(stderr, "kernel_launch: occupancy query says %d blocks/CU\n", per_cu); per_cu = 1; }
        grid_blocks = cus * 1;
    }
    if (grid_blocks < 0) return;
    Params p{};
    p.x = (const float*)d_in[0]; p.ffn1_norm = (const float*)d_in[1]; p.ffn1_wg = (const float*)d_in[2]; p.ffn1_wu = (const float*)d_in[3]; p.ffn1_wd = (const float*)d_in[4];
    p.mix_norm = (const float*)d_in[5]; p.w_in = (const float*)d_in[6]; p.lbf = (const float*)d_in[7]; p.lbb = (const float*)d_in[8]; p.rg_norm = (const float*)d_in[9];
    p.sink = (const float*)d_in[10]; p.wa = (const float*)d_in[11]; p.wb = (const float*)d_in[12]; p.wout = (const float*)d_in[13];
    p.ffn2_norm = (const float*)d_in[14]; p.ffn2_wg = (const float*)d_in[15]; p.ffn2_wu = (const float*)d_in[16]; p.ffn2_wd = (const float*)d_in[17]; p.final_norm = (const float*)d_in[18];
    p.out = (float*)d_out; p.ws = (unsigned char*)d_ws;
    if (hipMemsetAsync((char*)d_ws + WS_BAR, 0, 16384, stream) != hipSuccess) { fprintf(stderr, "kernel_launch: memset failed\n"); return; }
    void* args[] = {&p};
    hipError_t e = hipLaunchCooperativeKernel((const void*)fwd_megakernel, dim3(grid_blocks), dim3(NTHREADS), args, LDS_BYTES, stream);
    if (e != hipSuccess) fprintf(stderr, "cooperative launch failed: %s (grid %d)\n", hipGetErrorString(e), grid_blocks);
}
```

```cpp
#include <hip/hip_runtime.h>
#include <hip/hip_cooperative_groups.h>
#include <cstdio>
namespace cg = cooperative_groups;

#define LAS __attribute__((address_space(3)))
typedef unsigned short bf16_t;
typedef short bf16x8 __attribute__((ext_vector_type(8)));
typedef short bf16x4 __attribute__((ext_vector_type(4)));
typedef float f32x4 __attribute__((ext_vector_type(4)));
typedef float f32x2 __attribute__((ext_vector_type(2)));
typedef unsigned u32x4 __attribute__((ext_vector_type(4)));
typedef unsigned u32x2 __attribute__((ext_vector_type(2)));

constexpr int T = 8192, D = 2048, FF = 5632, INC = 10752, SEQ = 2048, RGW = 1024;
constexpr float EPS = 1e-6f;
constexpr int NTHREADS = 512, NWAVES = 8;
constexpr int LDS_BAR_OFF = 155648;
constexpr int LDS_BYTES = LDS_BAR_OFF + 16;

constexpr int PC_Q = 0, PC_I = 1024, PC_ZF = 2048, PC_ZB = 3072, PC_G = 4096, PC_AQ = 5120, PC_AK = 6144, PC_AV = 6400, PC_GA = 6656, PC_GB = 8704;

constexpr size_t SZ_WGU = (size_t)2 * FF * D * 2, SZ_WD = (size_t)D * FF * 2, SZ_WIN = (size_t)INC * D * 2, SZ_WAB = (size_t)D * RGW * 2, SZ_WOUT = (size_t)D * D * 2;
constexpr size_t OFF_WGU1 = 0, OFF_WD1 = OFF_WGU1 + SZ_WGU, OFF_WIN = OFF_WD1 + SZ_WD, OFF_WA = OFF_WIN + SZ_WIN, OFF_WB = OFF_WA + SZ_WAB, OFF_WOUT = OFF_WB + SZ_WAB,
                 OFF_WGU2 = OFF_WOUT + SZ_WOUT, OFF_WD2 = OFF_WGU2 + SZ_WGU, SZ_LAYER = OFF_WD2 + SZ_WD;
constexpr size_t WS_X = 2 * SZ_LAYER, WS_XB = WS_X + (size_t)T * D * 4, WS_SS = WS_XB + (size_t)T * D * 2, WS_BAR = WS_SS + (size_t)8 * T * 8, WS_REG = WS_BAR + 16384;
constexpr size_t WS_ACT = WS_REG;
constexpr size_t WS_P = WS_REG;
constexpr size_t WS_OF = WS_P + (size_t)T * INC * 2;
constexpr size_t WS_OB = WS_OF + (size_t)T * RGW * 4;
constexpr size_t WS_OA = WS_OB + (size_t)T * RGW * 4;
constexpr size_t WS_OT = WS_OA + (size_t)T * RGW * 2;
constexpr size_t WS_MG = WS_OT + (size_t)T * RGW * 2;
constexpr size_t WS_END = WS_MG + (size_t)T * D * 2;

struct Params {
    const float* x; const float* ffn1_norm; const float* ffn1_wg; const float* ffn1_wu; const float* ffn1_wd; const float* mix_norm; const float* w_in;
    const float* lbf; const float* lbb; const float* rg_norm; const float* sink; const float* wa; const float* wb; const float* wout;
    const float* ffn2_norm; const float* ffn2_wg; const float* ffn2_wu; const float* ffn2_wd; const float* final_norm;
    float* out; unsigned char* ws;
};

__device__ __forceinline__ unsigned pk2(float lo, float hi) { unsigned r; asm("v_cvt_pk_bf16_f32 %0, %1, %2" : "=v"(r) : "v"(lo), "v"(hi)); return r; }
__device__ __forceinline__ float bf_lo(unsigned w) { return __uint_as_float(w << 16); }
__device__ __forceinline__ float bf_hi(unsigned w) { return __uint_as_float(w & 0xffff0000u); }
__device__ __forceinline__ float bf1(bf16_t w) { return __uint_as_float(((unsigned)w) << 16); }
__device__ __forceinline__ float wave_sum(float v) {
#pragma unroll
    for (int o = 1; o < 64; o <<= 1) v += __shfl_xor(v, o);
    return v;
}
__device__ __forceinline__ float fexp(float v) { return __builtin_amdgcn_exp2f(v * 1.4426950408889634f); }
__device__ __forceinline__ float flog(float v) { return __builtin_amdgcn_logf(v) * 0.6931471805599453f; }
__device__ __forceinline__ float sigmoidf_(float v) { return __builtin_amdgcn_rcpf(1.0f + fexp(-v)); }
#define LDS_WAIT() asm volatile("s_waitcnt lgkmcnt(0)" ::: "memory")
#define LDS_BARRIER() do { asm volatile("s_waitcnt lgkmcnt(0)" ::: "memory"); __builtin_amdgcn_s_barrier(); asm volatile("" ::: "memory"); } while (0)
__device__ __forceinline__ int opaque_tid() { int t = threadIdx.x; asm volatile("" : "+v"(t)); return t; }


#define XB_TMO      128
#define XB_XCNT(j)  (256  + 64 * (j))
#define XB_XSUB(j)  (1280 + 64 * (j))
#define XB_XGEN(j)  (2304 + 64 * (j))
#define XB_TOP      3328
#define XB_TOPGEN   3392
#define XCD_BAR_WORDS 3456
#define XB_SPIN_CAP (1u << 22)
__device__ __forceinline__ unsigned xb_ld(unsigned* p)              { return __hip_atomic_load(p, __ATOMIC_RELAXED, __HIP_MEMORY_SCOPE_AGENT); }
__device__ __forceinline__ unsigned xb_add(unsigned* p, unsigned v) { return __hip_atomic_fetch_add(p, v, __ATOMIC_RELAXED, __HIP_MEMORY_SCOPE_AGENT); }
__device__ __forceinline__ unsigned xb_xcc_id() { return (unsigned)__builtin_amdgcn_s_getreg((3 << 11) | 20) & 0xFu; }
#define XB_SPIN(cond, bar) do { unsigned _sp = 0; while (cond) { __builtin_amdgcn_s_sleep(1); \
    if ((++_sp & 255u) == 0u) { if (xb_ld(&(bar)[XB_TMO])) break; if (_sp > XB_SPIN_CAP) { atomicAdd(&(bar)[XB_TMO], 1u); break; } } } } while (0)
struct XcdBarrier { unsigned* bar; unsigned x; volatile LAS unsigned* st; };
__device__ __forceinline__ XcdBarrier xcd_barrier_post(unsigned* bar, volatile LAS unsigned* st) {
    XcdBarrier b; b.bar = bar; b.x = xb_xcc_id(); b.st = st;
    if (threadIdx.x == 0) (void)xb_add(&bar[XB_XCNT(b.x)], 1u);
    return b;
}
__device__ __forceinline__ void xcd_barrier_complete(unsigned* bar, unsigned x, unsigned& nloc, unsigned& nx) {
    const unsigned G = gridDim.x * gridDim.y * gridDim.z;
    unsigned sum, cnt, mine, sp = 0u;
    for (;;) {
        sum = 0u; cnt = 0u; mine = 0u;
#pragma unroll
        for (unsigned j = 0; j < 16; ++j) { const unsigned c = xb_ld(&bar[XB_XCNT(j)]); sum += c; cnt += (c > 0u) ? 1u : 0u; mine = (j == x) ? c : mine; }
        if (sum == G) break;
        __builtin_amdgcn_s_sleep(1);
        if ((++sp & 255u) == 0u) { if (xb_ld(&bar[XB_TMO])) break; if (sp > XB_SPIN_CAP) { atomicAdd(&bar[XB_TMO], 1u); break; } }
    }
    nloc = mine > 0u ? mine : 1u; nx = cnt > 0u ? cnt : 1u;
}
__device__ __forceinline__ void xcd_barrier(const XcdBarrier& b) {
    asm volatile("s_waitcnt vmcnt(0)" ::: "memory");
    __syncthreads();
    if (threadIdx.x == 0) {
        unsigned* bar = b.bar; unsigned bx = b.x; asm volatile("" : "+s"(bx));
        __builtin_amdgcn_s_waitcnt(0);
        unsigned nloc = b.st[0], nx = b.st[1];
        if (nloc == 0u) { xcd_barrier_complete(bar, bx, nloc, nx); b.st[0] = nloc; b.st[1] = nx; }
        const unsigned old = xb_add(&bar[XB_XSUB(bx)], 1u);
        const unsigned gen = old / nloc;
        if (old + 1u == (gen + 1u) * nloc) {
            __builtin_amdgcn_fence(__ATOMIC_RELEASE, "agent");
            asm volatile("s_waitcnt vmcnt(0)" ::: "memory");
            const unsigned og = xb_add(&bar[XB_TOP], 1u);
            const unsigned tg = og / nx;
            if (og + 1u == (tg + 1u) * nx) xb_add(&bar[XB_TOPGEN], 1u);
            else XB_SPIN(xb_ld(&bar[XB_TOPGEN]) == tg, bar);
            __builtin_amdgcn_fence(__ATOMIC_ACQUIRE, "agent");
            xb_add(&bar[XB_XGEN(bx)], 1u);
            asm volatile("s_waitcnt vmcnt(0)" ::: "memory");
        } else {
            XB_SPIN(xb_ld(&bar[XB_XGEN(bx)]) == gen, bar);
            __builtin_amdgcn_fence(__ATOMIC_ACQUIRE, "agent");
            asm volatile("s_waitcnt vmcnt(0)" ::: "memory");
        }
    }
    __syncthreads();
}

namespace pg8 {
constexpr int BM = 256, BK = 64, HALF = 128, HTB = HALF * BK * 2, STAGE_BYTES = 8 * HTB, NXCD = 8, WGM = 8;
__host__ __device__ __forceinline__ int lds_byte(int r, int c) { const int st = (r >> 4) * 2 + (c >> 5), rr = r & 15, cc = c & 31, ob = rr * 64 + cc * 2; return st * 1024 + (ob ^ (((ob >> 9) & 1) << 5)); }
__host__ __device__ __forceinline__ void stage_rc(int b, int& R, int& C) { const int st = b / 1024, sb = b % 1024, swz = sb ^ (((sb >> 9) & 1) << 5); R = (st >> 1) * 16 + swz / 64; C = (st & 1) * 32 + (swz % 64) / 2; }
__host__ __device__ __forceinline__ int perm32(int rho) { const int n = rho >> 4, i = rho & 15; return 8 * (i >> 2) + 4 * n + (i & 3); }

struct Unit { int pm, pn, kind; };
struct Gemm { const bf16_t* A0; const bf16_t* B0; const bf16_t* A1; const bf16_t* B1; int M, N, K; };

struct StaticOrder {
    int nM, nN, nwg, G, c;
    __device__ void init(int M, int N, int G_, int c_) { nM = M / BM; nN = N / BM; nwg = nM * nN; G = G_; c = c_; }
    __device__ bool next(int i, Unit& u) const {
        const long L = (long)i * G + c; if (L >= nwg) return false;
        int wgid = (int)L; { const int q = nwg / NXCD, r = nwg % NXCD, xcd = wgid % NXCD, off = wgid / NXCD; wgid = (xcd < r ? xcd * (q + 1) : r * (q + 1) + (xcd - r) * q) + off; }
        const int nig = WGM * nN, gid = wgid / nig, fm = gid * WGM, gsz = (nM - fm) < WGM ? (nM - fm) : WGM;
        u.pm = fm + ((wgid % nig) % gsz); u.pn = (wgid % nig) / gsz; u.kind = 0; return true;
    }
};
struct PairOrder {
    StaticOrder so;
    __device__ void init(int M, int N, int G_, int c_) { so.init(M, N, G_, c_); }
    __device__ bool next(int i, Unit& u) const { if (!so.next(i >> 1, u)) return false; u.kind = i & 1; return true; }
};

template <class Epi, class Sched, bool ALIGN_EPI = true, bool SP2 = true>
__device__ __forceinline__ void gemm_phase(LAS unsigned char* lds, const Gemm g, const Sched& S, const Epi& E) {
    const int tid = opaque_tid(), wid = __builtin_amdgcn_readfirstlane(tid >> 6), lane = tid & 63, wr = wid >> 2, wc = wid & 3, fr = lane & 15, fq = lane >> 4;
    const int K = g.K, nt = K / BK;
    unsigned voffA[2], voffB[2];
#pragma unroll
    for (int i = 0; i < 2; ++i) { int R, C; stage_rc(tid * 16 + i * 8192, R, C); const int Rb = Epi::PERM ? ((R & ~31) + perm32(R & 31)) : R;
        voffA[i] = (unsigned)(R * K + C) * 2u; voffB[i] = (unsigned)(Rb * K + C) * 2u; }
    const size_t kstep = (size_t)(BK * 2);
    const size_t hstep = (size_t)HALF * K * 2;
    const size_t tstep = 2 * hstep;
    const unsigned ldsw = (unsigned)wid * 1024u;
    const int aoff = lds_byte(wr * 64 + fr, fq * 8), boff = lds_byte(wc * 32 + fr, fq * 8);
#define PG8_SA(b, h) (((b) * 2 + (h)) * HTB)
#define PG8_SB(b, h) ((4 + (b) * 2 + (h)) * HTB)
#define PG8_STAGE(bufoff, gbase, voff) do { _Pragma("unroll") for (int _i = 0; _i < 2; ++_i) \
        __builtin_amdgcn_global_load_lds((const unsigned*)((const char*)(gbase) + (voff)[_i]), (LAS unsigned*)(lds + (bufoff) + ldsw + _i * 8192), 16, 0, 0); } while (0)
#define PG8_LDA(dst, b, h) do { _Pragma("unroll") for (int m = 0; m < 4; ++m) _Pragma("unroll") for (int k = 0; k < 2; ++k) dst[m][k] = *(const LAS bf16x8*)(lds + PG8_SA(b, h) + aoff + m * 2048 + k * 1024); } while (0)
#define PG8_LDB(dst, b, h) do { _Pragma("unroll") for (int n = 0; n < 2; ++n) _Pragma("unroll") for (int k = 0; k < 2; ++k) dst[n][k] = *(const LAS bf16x8*)(lds + PG8_SB(b, h) + boff + n * 2048 + k * 1024); } while (0)
#define PG8_MMA(ai, bj, At, Bt) do { __builtin_amdgcn_s_setprio(1); _Pragma("unroll") for (int m = 0; m < 4; ++m) _Pragma("unroll") for (int n = 0; n < 2; ++n) _Pragma("unroll") for (int k = 0; k < 2; ++k) \
        acc[ai][bj][m][n] = __builtin_amdgcn_mfma_f32_16x16x32_bf16(Bt[n][k], At[m][k], acc[ai][bj][m][n], 0, 0, 0); __builtin_amdgcn_s_setprio(0); } while (0)
#define PG8_WAIT_V(n) asm volatile("s_waitcnt vmcnt(" #n ")" ::: "memory")
#define PG8_WAIT_L(n) asm volatile("s_waitcnt lgkmcnt(" #n ")" ::: "memory")
#define PG8_BAR __builtin_amdgcn_s_barrier()
#define PG8_SCHED __builtin_amdgcn_sched_barrier(0)
    Unit cur, nxt; int ui = 0;
    if (!S.next(0, cur)) return;
    f32x4 acc[2][2][4][2];
#pragma unroll
    for (int a = 0; a < 2; ++a)
#pragma unroll
        for (int b = 0; b < 2; ++b)
#pragma unroll
            for (int m = 0; m < 4; ++m)
#pragma unroll
                for (int n = 0; n < 2; ++n) acc[a][b][m][n] = (f32x4){0.f, 0.f, 0.f, 0.f};
    bf16x8 At[4][2], B0[2][2], B1[2][2];
    const char* cA = (const char*)(cur.kind ? g.A1 : g.A0) + (size_t)cur.pm * tstep; const char* cB = (const char*)(cur.kind ? g.B1 : g.B0) + (size_t)cur.pn * tstep;
    if constexpr (SP2) {
        PG8_STAGE(PG8_SB(0, 0), cB, voffB); PG8_STAGE(PG8_SB(0, 1), cB + hstep, voffB); PG8_STAGE(PG8_SA(0, 0), cA, voffA); PG8_STAGE(PG8_SA(0, 1), cA + hstep, voffA);
        if (wr == 1) PG8_BAR;
        PG8_WAIT_V(2); PG8_BAR;
        PG8_STAGE(PG8_SB(1, 0), cB + kstep, voffB); PG8_STAGE(PG8_SA(1, 0), cA + kstep, voffA); PG8_STAGE(PG8_SB(1, 1), cB + hstep + kstep, voffB);
        PG8_WAIT_V(6); PG8_BAR;
    } else {
    PG8_STAGE(PG8_SB(0, 0), cB, voffB); PG8_STAGE(PG8_SA(0, 0), cA, voffA); PG8_STAGE(PG8_SB(0, 1), cB + hstep, voffB); PG8_STAGE(PG8_SA(0, 1), cA + hstep, voffA);
    if (wr == 1) PG8_BAR;
    PG8_WAIT_V(4); PG8_BAR;
    PG8_STAGE(PG8_SB(1, 0), cB + kstep, voffB); PG8_STAGE(PG8_SA(1, 0), cA + kstep, voffA); PG8_STAGE(PG8_SB(1, 1), cB + hstep + kstep, voffB);
    PG8_WAIT_V(6); PG8_BAR;
    }
    for (;;) {
        const bool has_next = S.next(ui + 1, nxt);
        const char* nA = has_next ? (const char*)(nxt.kind ? g.A1 : g.A0) + (size_t)nxt.pm * tstep : cA; const char* nB = has_next ? (const char*)(nxt.kind ? g.B1 : g.B0) + (size_t)nxt.pn * tstep : cB;
        for (int t = 0; t < nt; t += 2) {
            const bool last = (t == nt - 2);
            const char* a1 = cA + (size_t)(t + 1) * kstep;
            const char* a2 = last ? nA : cA + (size_t)(t + 2) * kstep; const char* b2 = last ? nB : cB + (size_t)(t + 2) * kstep;
            const char* a3 = a2 + kstep; const char* b3 = b2 + kstep;
            if constexpr (SP2) {
            PG8_LDB(B0, 0, 0); PG8_LDB(B1, 0, 1); PG8_SCHED; PG8_LDA(At, 0, 0); PG8_STAGE(PG8_SA(1, 1), a1 + hstep, voffA);
            PG8_WAIT_V(8); PG8_WAIT_L(0); PG8_BAR; PG8_MMA(0, 0, At, B0); PG8_MMA(0, 1, At, B1); PG8_BAR; PG8_SCHED;
            PG8_LDA(At, 0, 1); PG8_STAGE(PG8_SB(0, 0), b2, voffB); PG8_STAGE(PG8_SB(0, 1), b2 + hstep, voffB); PG8_STAGE(PG8_SA(0, 0), a2, voffA);
            PG8_WAIT_V(8); PG8_WAIT_L(0); PG8_BAR; PG8_MMA(1, 0, At, B0); PG8_MMA(1, 1, At, B1); PG8_BAR; PG8_SCHED;
            PG8_LDB(B0, 1, 0); PG8_LDB(B1, 1, 1); PG8_SCHED; PG8_LDA(At, 1, 0); PG8_STAGE(PG8_SA(0, 1), a2 + hstep, voffA);
            PG8_WAIT_V(8); PG8_WAIT_L(0); PG8_BAR; PG8_MMA(0, 0, At, B0); PG8_MMA(0, 1, At, B1); PG8_BAR; PG8_SCHED;
            PG8_LDA(At, 1, 1); PG8_STAGE(PG8_SB(1, 0), b3, voffB); PG8_STAGE(PG8_SB(1, 1), b3 + hstep, voffB); PG8_STAGE(PG8_SA(1, 0), a3, voffA);
            PG8_WAIT_V(8); PG8_WAIT_L(0); PG8_BAR; PG8_MMA(1, 0, At, B0); PG8_MMA(1, 1, At, B1); PG8_BAR; PG8_SCHED;
            } else {
            PG8_LDB(B0, 0, 0); PG8_SCHED; PG8_LDA(At, 0, 0); PG8_STAGE(PG8_SA(1, 1), a1 + hstep, voffA);
            PG8_WAIT_L(8); PG8_BAR; PG8_WAIT_L(0); PG8_MMA(0, 0, At, B0); PG8_BAR; PG8_SCHED;
            PG8_LDB(B1, 0, 1); PG8_STAGE(PG8_SB(0, 0), b2, voffB);
            PG8_BAR; PG8_WAIT_L(0); PG8_MMA(0, 1, At, B1); PG8_BAR;
            PG8_LDA(At, 0, 1); PG8_STAGE(PG8_SA(0, 0), a2, voffA);
            PG8_BAR; PG8_WAIT_L(0); PG8_MMA(1, 0, At, B0); PG8_BAR; PG8_SCHED;
            PG8_STAGE(PG8_SB(0, 1), b2 + hstep, voffB);
            PG8_WAIT_V(6); PG8_BAR; PG8_MMA(1, 1, At, B1); PG8_BAR;
            PG8_LDB(B0, 1, 0); PG8_SCHED; PG8_LDA(At, 1, 0); PG8_STAGE(PG8_SA(0, 1), a2 + hstep, voffA);
            PG8_WAIT_L(8); PG8_BAR; PG8_WAIT_L(0); PG8_MMA(0, 0, At, B0); PG8_BAR; PG8_SCHED;
            PG8_LDB(B1, 1, 1); PG8_STAGE(PG8_SB(1, 0), b3, voffB);
            PG8_BAR; PG8_WAIT_L(0); PG8_MMA(0, 1, At, B1); PG8_BAR;
            PG8_LDA(At, 1, 1); PG8_STAGE(PG8_SA(1, 0), a3, voffA);
            PG8_BAR; PG8_WAIT_L(0); PG8_MMA(1, 0, At, B0); PG8_BAR; PG8_SCHED;
            PG8_STAGE(PG8_SB(1, 1), b3 + hstep, voffB);
            PG8_WAIT_V(6); PG8_BAR; PG8_MMA(1, 1, At, B1); PG8_BAR;
            }
        }
        if constexpr (ALIGN_EPI) { if (wr == 0) PG8_BAR; }
        const bool keep = E(acc, cur, wr, wc, fr, fq);
        if (!has_next) break;
        if (!keep) {
#pragma unroll
        for (int a = 0; a < 2; ++a)
#pragma unroll
            for (int b = 0; b < 2; ++b)
#pragma unroll
                for (int m = 0; m < 4; ++m)
#pragma unroll
                    for (int n = 0; n < 2; ++n) acc[a][b][m][n] = (f32x4){0.f, 0.f, 0.f, 0.f};
        }
        cur = nxt; cA = nA; cB = nB; ++ui;
        if constexpr (ALIGN_EPI) { if (wr == 1) PG8_BAR; }
    }
    PG8_WAIT_V(0);
    if constexpr (!ALIGN_EPI) { if (wr == 0) PG8_BAR; }
    PG8_BAR;
#undef PG8_SA
#undef PG8_SB
#undef PG8_STAGE
#undef PG8_LDA
#undef PG8_LDB
#undef PG8_MMA
#undef PG8_WAIT_V
#undef PG8_WAIT_L
#undef PG8_BAR
#undef PG8_SCHED
}
}

typedef unsigned long long ssq_t;
constexpr float SSQ_SCALE = 16777216.0f;
__device__ __forceinline__ ssq_t ssq_fix(float s) { return (ssq_t)(s * SSQ_SCALE + 0.5f); }
__device__ __forceinline__ float row_rstd(const ssq_t* ss, int row) { return rsqrtf((float)ss[row] * (1.0f / SSQ_SCALE) * (1.0f / D) + EPS); }

struct EpiGU {
    static constexpr bool PERM = true;
    const ssq_t* ss; bf16_t* act;
    __device__ __forceinline__ bool operator()(f32x4 (&acc)[2][2][4][2], const pg8::Unit& u, int wr, int wc, int fr, int fq) const {
        const int row0 = u.pm * 256 + wr * 64 + fr, col0 = u.pn * 128 + wc * 32 + 8 * fq;
#pragma unroll
        for (int ai = 0; ai < 2; ++ai)
#pragma unroll
            for (int m = 0; m < 4; ++m) {
                const int row = row0 + ai * 128 + m * 16; const float r = row_rstd(ss, row);
                float o[8];
#pragma unroll
                for (int n = 0; n < 2; ++n)
#pragma unroll
                    for (int j = 0; j < 4; ++j) { const float gv = acc[ai][0][m][n][j] * r, uv = acc[ai][1][m][n][j] * r; o[n * 4 + j] = gv * sigmoidf_(gv) * uv; }
                u32x4 w; w.x = pk2(o[0], o[1]); w.y = pk2(o[2], o[3]); w.z = pk2(o[4], o[5]); w.w = pk2(o[6], o[7]);
                *(u32x4*)(act + (size_t)row * FF + col0) = w;
            }
        return false;
    }
};
struct EpiRes {
    static constexpr bool PERM = false;
    const float* xin32; bf16_t* xb; ssq_t* ss_out; float scale;
    __device__ __forceinline__ bool operator()(f32x4 (&acc)[2][2][4][2], const pg8::Unit& u, int wr, int wc, int fr, int fq) const {
        const int row0 = u.pm * 256 + wr * 64 + fr, col0 = u.pn * 256 + wc * 32 + 4 * fq;
#pragma unroll
        for (int ai = 0; ai < 2; ++ai)
#pragma unroll
            for (int m = 0; m < 4; ++m) {
                const int row = row0 + ai * 128 + m * 16; float s = 0.f;
#pragma unroll
                for (int bj = 0; bj < 2; ++bj)
#pragma unroll
                    for (int n = 0; n < 2; ++n) {
                        const size_t off = (size_t)row * D + col0 + bj * 128 + n * 16;
                        f32x4 xv;
                        if (xin32) xv = __builtin_nontemporal_load((const f32x4*)(xin32 + off));
                        else { const u32x2 wi = *(const u32x2*)(xb + off); xv = (f32x4){bf_lo(wi.x), bf_hi(wi.x), bf_lo(wi.y), bf_hi(wi.y)}; }
                        xv = xv + acc[ai][bj][m][n] * scale;
                        u32x2 w; w.x = pk2(xv[0], xv[1]); w.y = pk2(xv[2], xv[3]); *(u32x2*)(xb + off) = w;
                        const float r0 = bf_lo(w.x), r1 = bf_hi(w.x), r2 = bf_lo(w.y), r3 = bf_hi(w.y);
                        s += (r0 * r0 + r1 * r1) + (r2 * r2 + r3 * r3);
                    }
                s += __shfl_xor(s, 16); s += __shfl_xor(s, 32);
                if (fq == 0) __hip_atomic_fetch_add(ss_out + row, ssq_fix(s), __ATOMIC_RELAXED, __HIP_MEMORY_SCOPE_AGENT);
            }
        return false;
    }
};
struct EpiP {
    static constexpr bool PERM = true;
    const ssq_t* ss; bf16_t* P;
    __device__ __forceinline__ bool operator()(f32x4 (&acc)[2][2][4][2], const pg8::Unit& u, int wr, int wc, int fr, int fq) const {
        const int row0 = u.pm * 256 + wr * 64 + fr, col0 = u.pn * 256 + wc * 32 + 8 * fq;
#pragma unroll
        for (int ai = 0; ai < 2; ++ai)
#pragma unroll
            for (int m = 0; m < 4; ++m) {
                const int row = row0 + ai * 128 + m * 16; const float r = row_rstd(ss, row);
#pragma unroll
                for (int bj = 0; bj < 2; ++bj) {
                    const f32x4 v0 = acc[ai][bj][m][0] * r, v1 = acc[ai][bj][m][1] * r;
                    u32x4 w; w.x = pk2(v0[0], v0[1]); w.y = pk2(v0[2], v0[3]); w.z = pk2(v1[0], v1[1]); w.w = pk2(v1[2], v1[3]);
                    *(u32x4*)(P + (size_t)row * INC + col0 + bj * 128) = w;
                }
            }
        return false;
    }
};
struct EpiMerge {
    static constexpr bool PERM = true;
    const bf16_t* P; bf16_t* mg;
    __device__ __forceinline__ bool operator()(f32x4 (&acc)[2][2][4][2], const pg8::Unit& u, int wr, int wc, int fr, int fq) const {
        const int row0 = u.pm * 256 + wr * 64 + fr, col0 = u.pn * 256 + wc * 32 + 8 * fq;
#pragma unroll
        for (int ai = 0; ai < 2; ++ai)
#pragma unroll
            for (int m = 0; m < 4; ++m) {
                const int row = row0 + ai * 128 + m * 16;
#pragma unroll
                for (int bj = 0; bj < 2; ++bj) {
                    const int col = col0 + bj * 128;
                    const u32x4 gb = *(const u32x4*)(P + (size_t)row * INC + PC_GB + col);
                    if (u.kind == 0) {
                        const u32x4 ga = __builtin_nontemporal_load((const u32x4*)(P + (size_t)row * INC + PC_GA + col));
#pragma unroll
                        for (int q = 0; q < 4; ++q) {
                            const float a0 = bf_lo(ga[q]), a1 = bf_hi(ga[q]), b0 = bf_lo(gb[q]), b1 = bf_hi(gb[q]);
                            const float r0 = (1.0f + fexp(-b0)) * __builtin_amdgcn_rcpf(1.0f + fexp(-a0));
                            const float r1 = (1.0f + fexp(-b1)) * __builtin_amdgcn_rcpf(1.0f + fexp(-a1));
                            acc[ai][bj][m][q >> 1][(q & 1) * 2 + 0] *= r0; acc[ai][bj][m][q >> 1][(q & 1) * 2 + 1] *= r1;
                        }
                    } else {
                        float o[8];
#pragma unroll
                        for (int q = 0; q < 4; ++q) {
                            o[2 * q] = acc[ai][bj][m][q >> 1][(q & 1) * 2 + 0] * sigmoidf_(bf_lo(gb[q]));
                            o[2 * q + 1] = acc[ai][bj][m][q >> 1][(q & 1) * 2 + 1] * sigmoidf_(bf_hi(gb[q]));
                        }
                        u32x4 w; w.x = pk2(o[0], o[1]); w.y = pk2(o[2], o[3]); w.z = pk2(o[4], o[5]); w.w = pk2(o[6], o[7]);
                        *(u32x4*)(mg + (size_t)row * D + col) = w;
                    }
                }
            }
        return u.kind == 0;
    }
};

__device__ __forceinline__ void p0_item(const float* W, const float* gain, int K, int N, bf16_t* WT, int mode, LAS float* scr, int item, int lane) {
    const int nblk = N / 64, kb = item / nblk, nb = item % nblk, k0 = 64 * kb, n0 = 64 * nb;
    const int kr = lane >> 4, nc = (lane & 15) * 4;
    f32x4 v[16];
#pragma unroll
    for (int i = 0; i < 16; ++i) v[i] = __builtin_nontemporal_load((const f32x4*)(W + (size_t)(k0 + 4 * i + kr) * N + n0 + nc));
    if (gain) {
#pragma unroll
        for (int i = 0; i < 16; ++i) v[i] = v[i] * gain[k0 + 4 * i + kr];
    }
#pragma unroll
    for (int i = 0; i < 16; ++i) { LAS float* s = scr + (4 * i + kr) * 65 + nc; s[0] = v[i][0]; s[1] = v[i][1]; s[2] = v[i][2]; s[3] = v[i][3]; }
    LDS_WAIT();
    const int c = lane & 7;
    const int rbase = (mode == 0) ? n0 : ((n0 >> 7) * 256 + (mode == 2 ? 128 : 0) + (n0 & 127));
#pragma unroll
    for (int j = 0; j < 8; ++j) { const int n = (lane >> 3) + 8 * j; const LAS float* s = scr + (8 * c) * 65 + n;
        u32x4 o; o.x = pk2(s[0 * 65], s[1 * 65]); o.y = pk2(s[2 * 65], s[3 * 65]); o.z = pk2(s[4 * 65], s[5 * 65]); o.w = pk2(s[6 * 65], s[7 * 65]);
        __builtin_nontemporal_store(o, (u32x4*)(WT + (size_t)(rbase + n) * K + k0 + 8 * c)); }
    LDS_WAIT();
}

constexpr int I_FF = (D / 64) * (FF / 64), I_DN = (FF / 64) * (D / 64), I_IN = (D / 64) * (INC / 64), I_AB = (RGW / 64) * (D / 64), I_OUT = (D / 64) * (D / 64);
constexpr int I_A = 2 * I_FF + I_DN + I_IN;
constexpr int I_LAYER = 4 * I_FF + 2 * I_DN + I_IN + 2 * I_AB + I_OUT;
constexpr int I_P0 = 2 * I_FF;
constexpr int I_CUT2 = I_LAYER + 2 * I_FF;
__device__ __forceinline__ void convert_items(const Params& p, LAS unsigned char* lds, int lo, int hi, int wv, int nwv) {
    const int tid = opaque_tid(), lane = tid & 63, wave = tid >> 6;
    LAS float* scr = (LAS float*)(lds + wave * 16640);
    for (int it = lo + wv; it < hi; it += nwv) {
        const int l = it >= I_LAYER ? 1 : 0; int r = it - l * I_LAYER;
        bf16_t* wl = (bf16_t*)(p.ws + (size_t)l * SZ_LAYER);
        const float* W; const float* gain = nullptr; int K, N, mode = 0; size_t off;
        if (r < I_FF) { W = p.ffn1_wg + (size_t)l * D * FF; gain = p.ffn1_norm + l * D; K = D; N = FF; mode = 1; off = OFF_WGU1; }
        else if ((r -= I_FF) < I_FF) { W = p.ffn1_wu + (size_t)l * D * FF; gain = p.ffn1_norm + l * D; K = D; N = FF; mode = 2; off = OFF_WGU1; }
        else if ((r -= I_FF) < I_DN) { W = p.ffn1_wd + (size_t)l * D * FF; K = FF; N = D; off = OFF_WD1; }
        else if ((r -= I_DN) < I_IN) { W = p.w_in + (size_t)l * D * INC; gain = p.mix_norm + l * D; K = D; N = INC; off = OFF_WIN; }
        else if ((r -= I_IN) < I_AB) { W = p.wa + (size_t)l * RGW * D; K = RGW; N = D; off = OFF_WA; }
        else if ((r -= I_AB) < I_AB) { W = p.wb + (size_t)l * RGW * D; K = RGW; N = D; off = OFF_WB; }
        else if ((r -= I_AB) < I_OUT) { W = p.wout + (size_t)l * D * D; K = D; N = D; off = OFF_WOUT; }
        else if ((r -= I_OUT) < I_FF) { W = p.ffn2_wg + (size_t)l * D * FF; gain = p.ffn2_norm + l * D; K = D; N = FF; mode = 1; off = OFF_WGU2; }
        else if ((r -= I_FF) < I_FF) { W = p.ffn2_wu + (size_t)l * D * FF; gain = p.ffn2_norm + l * D; K = D; N = FF; mode = 2; off = OFF_WGU2; }
        else { r -= I_FF; W = p.ffn2_wd + (size_t)l * D * FF; K = FF; N = D; off = OFF_WD2; }
        p0_item(W, gain, K, N, (bf16_t*)((unsigned char*)wl + off), mode, scr, r, lane);
    }
}
__device__ __forceinline__ void tail_convert(const Params& p, LAS unsigned char* lds, int nunits, int G, int c, int lo, int hi) {
    const int rem = nunits % G, wave = opaque_tid() >> 6;
    if (rem != 0 && c < rem) return;
    convert_items(p, lds, lo, hi, (c - rem) * NWAVES + wave, (G - rem) * NWAVES);
}

__device__ __forceinline__ void p0_prologue(const Params& p, LAS unsigned char* lds, int G) {
    const int tid = opaque_tid(), lane = tid & 63, wave = tid >> 6;
    const int gw = blockIdx.x * NWAVES + wave, NGW = G * NWAVES;
    convert_items(p, lds, 0, I_P0, gw, NGW);
    ssq_t* ss = (ssq_t*)(p.ws + WS_SS); bf16_t* xb = (bf16_t*)(p.ws + WS_XB);
    for (int row = gw; row < T; row += NGW) {
        const f32x4* xr = (const f32x4*)(p.x + (size_t)row * D) + lane; u32x2* o = (u32x2*)(xb + (size_t)row * D) + lane; float s = 0.f;
#pragma unroll
        for (int j = 0; j < 8; ++j) { const f32x4 v = __builtin_nontemporal_load(xr + 64 * j); s += (v[0] * v[0] + v[1] * v[1]) + (v[2] * v[2] + v[3] * v[3]); u32x2 w; w.x = pk2(v[0], v[1]); w.y = pk2(v[2], v[3]); o[64 * j] = w; }
        s = wave_sum(s); if (lane == 0) ss[row] = ssq_fix(s);
    }
    for (int i = blockIdx.x * NTHREADS + tid; i < 7 * T; i += G * NTHREADS) ss[T + i] = 0ull;
}

constexpr int H_QS = 272, H_TS = 144;
constexpr int HB_SZ = 62464, HB_QI = 0, HB_KI = 17408, HB_KIT = 34816, HB_VT = 53248;
constexpr int H_ST = 2 * HB_SZ, H_PM = H_ST + 17408, H_GT = H_PM + 9216;
static_assert(H_GT + 2 * 2048 <= LDS_BAR_OFF, "HGRN LDS image");
__device__ __forceinline__ void hgrn_chain(const Params& p, LAS unsigned char* lds, int layer, int chain, int dvh) {
    const int tid = opaque_tid(), lane = tid & 63, wave = __builtin_amdgcn_readfirstlane(tid >> 6), fr = lane & 15, fq = lane >> 4;
    const bf16_t* P = (const bf16_t*)(p.ws + WS_P);
    const int b = chain >> 4, h = (chain >> 1) & 7, dir = chain & 1;
    float* O = (float*)(p.ws + (dir ? WS_OB : WS_OF));
    const float* lbl = dir ? p.lbb : p.lbf;
    const int zc = (dir ? PC_ZB : PC_ZF) + h * 128;
    const int d = tid & 127, tg = tid >> 7;
    const int vs = tid & 63, vg = tid >> 6;
    float lb = 0.f;
    if (layer == 1) { const int ch = h * 128 + d; lb = sigmoidf_(lbl[RGW + ch] - lbl[ch]); }
    f32x4 Sacc[4];
#pragma unroll
    for (int i = 0; i < 4; ++i) Sacc[i] = (f32x4){0.f, 0.f, 0.f, 0.f};
    bf16_t zr[16], qr[16]; u32x4 vr0;
    float pb[16], kk_[16], qf[16]; u32x4 v0;
    const ptrdiff_t tstep_ = dir ? -(ptrdiff_t)INC : (ptrdiff_t)INC;
#define HG_TOK(c, j) ((size_t)b * SEQ + (dir ? ((SEQ / 64 - 1 - (c)) * 64 + 63 - (j)) : ((c) * 64 + (j))))
#define HG_LOAD(c) do { const bf16_t* zp_ = P + HG_TOK(c, tg * 16) * INC + zc + d; const bf16_t* qp_ = P + HG_TOK(c, tg * 16) * INC + PC_Q + h * 128 + d; \
        _Pragma("unroll") for (int i = 0; i < 16; ++i) { zr[i] = *zp_; qr[i] = *qp_; zp_ += tstep_; qp_ += tstep_; } \
        { const size_t tk = HG_TOK(c, vs); const bf16_t* vp = P + tk * INC + PC_I + h * 128 + dvh * 64 + vg * 8; vr0 = *(const u32x4*)vp; } } while (0)
#define HG_A1(g) do { LAS float* GT_ = (LAS float*)(lds + H_GT + (g) * 2048); float run = 1.f; \
        _Pragma("unroll") for (int i = 0; i < 16; ++i) { \
            const float z = fmaxf(bf1(zr[i]), -60.0f); const float e = fexp(-z), sg = __builtin_amdgcn_rcpf(1.0f + e); \
            const float f = lb + (1.0f - lb) * sg; kk_[i] = (1.0f - lb) * e * sg; run *= f; pb[i] = run; qf[i] = bf1(qr[i]); } \
        GT_[tg * 128 + d] = run; v0 = vr0; } while (0)
#define HG_A2(g, lb_) do { const LAS float* GT_ = (const LAS float*)(lds + H_GT + (g) * 2048); \
        const float g0 = GT_[d], g1 = GT_[128 + d], g2 = GT_[256 + d]; \
        const float den = (tg == 0) ? g0 * g1 : g1; \
        const float C = (tg >= 2) ? (tg == 3 ? g2 : 1.0f) : __builtin_amdgcn_rcpf(fmaxf(den, 1e-36f)); \
        unsigned kw[8]; \
        _Pragma("unroll") for (int i = 0; i < 16; i += 2) { \
            const float eq0 = fminf(fmaxf(pb[i] * C, 2.4e-35f), 4.15e34f), eq1 = fminf(fmaxf(pb[i + 1] * C, 2.4e-35f), 4.15e34f); \
            const float ek0 = __builtin_amdgcn_rcpf(eq0), ek1 = __builtin_amdgcn_rcpf(eq1); \
            const unsigned qw = pk2(qf[i] * eq0, qf[i + 1] * eq1); kw[i >> 1] = pk2(kk_[i] * ek0, kk_[i + 1] * ek1); \
            const int j = tg * 16 + i; \
            *(LAS bf16_t*)((lb_) + HB_QI + j * H_QS + d * 2) = (bf16_t)(qw & 0xffffu); *(LAS bf16_t*)((lb_) + HB_QI + (j + 1) * H_QS + d * 2) = (bf16_t)(qw >> 16); \
            *(LAS bf16_t*)((lb_) + HB_KI + j * H_QS + d * 2) = (bf16_t)(kw[i >> 1] & 0xffffu); *(LAS bf16_t*)((lb_) + HB_KI + (j + 1) * H_QS + d * 2) = (bf16_t)(kw[i >> 1] >> 16); } \
        u32x4 w0, w1; w0.x = kw[0]; w0.y = kw[1]; w0.z = kw[2]; w0.w = kw[3]; w1.x = kw[4]; w1.y = kw[5]; w1.z = kw[6]; w1.w = kw[7]; \
        *(LAS u32x4*)((lb_) + HB_KIT + d * H_TS + tg * 32) = w0; *(LAS u32x4*)((lb_) + HB_KIT + d * H_TS + tg * 32 + 16) = w1; \
        _Pragma("unroll") for (int q = 0; q < 4; ++q) { \
            *(LAS bf16_t*)((lb_) + HB_VT + (vg * 8 + 2 * q) * H_TS + vs * 2) = (bf16_t)(v0[q] & 0xffffu); *(LAS bf16_t*)((lb_) + HB_VT + (vg * 8 + 2 * q + 1) * H_TS + vs * 2) = (bf16_t)(v0[q] >> 16); } } while (0)
    HG_LOAD(0);
    HG_A1(0);
    HG_LOAD(1);
    LDS_BARRIER();
    HG_A2(0, lds);
    LDS_BARRIER();
    for (int c = 0; c < SEQ / 64; ++c) {
        const int cur = c & 1;
        LAS unsigned char* lc = lds + cur * HB_SZ;
        LAS unsigned char* ln = lds + (cur ^ 1) * HB_SZ;
        f32x4 eb, ec;
        {
            const LAS float* GT = (const LAS float*)(lds + H_GT + cur * 2048);
            const f32x4 g0 = *(const LAS f32x4*)(GT + wave * 16 + fq * 4), g1 = *(const LAS f32x4*)(GT + 128 + wave * 16 + fq * 4);
            const f32x4 g2 = *(const LAS f32x4*)(GT + 256 + wave * 16 + fq * 4), g3 = *(const LAS f32x4*)(GT + 384 + wave * 16 + fq * 4);
            eb = g0 * g1; ec = g2 * g3;
        }
#pragma unroll
        for (int dvt = 0; dvt < 4; ++dvt) {
            Sacc[dvt] = Sacc[dvt] * eb;
            u32x2 w; w.x = pk2(Sacc[dvt][0], Sacc[dvt][1]); w.y = pk2(Sacc[dvt][2], Sacc[dvt][3]);
            *(LAS u32x2*)(lds + H_ST + (dvt * 16 + fr) * H_QS + (wave * 16 + fq * 4) * 2) = w;
        }
        {
            const int tt = wave >> 1;
#pragma unroll
            for (int u = 0; u < 2; ++u) {
                const int st = (wave & 1) * 2 + u;
                f32x4 a4 = (f32x4){0.f, 0.f, 0.f, 0.f};
                if (st <= tt) {
#pragma unroll
                    for (int kk = 0; kk < 4; ++kk) {
                        const bf16x8 ka = *(const LAS bf16x8*)(lc + HB_KI + (st * 16 + fr) * H_QS + (kk * 32 + fq * 8) * 2);
                        const bf16x8 qb = *(const LAS bf16x8*)(lc + HB_QI + (tt * 16 + fr) * H_QS + (kk * 32 + fq * 8) * 2);
                        a4 = __builtin_amdgcn_mfma_f32_16x16x32_bf16(ka, qb, a4, 0, 0, 0);
                    }
                    const int t = tt * 16 + fr;
#pragma unroll
                    for (int j = 0; j < 4; ++j) { const int s = st * 16 + fq * 4 + j; a4[j] = (s <= t) ? a4[j] : 0.f; }
                }
                u32x2 w; w.x = pk2(a4[0], a4[1]); w.y = pk2(a4[2], a4[3]);
                *(LAS u32x2*)(lds + H_PM + (tt * 16 + fr) * H_TS + (st * 16 + fq * 4) * 2) = w;
            }
        }
        if (c + 1 < SEQ / 64) { HG_A1(cur ^ 1); if (c + 2 < SEQ / 64) HG_LOAD(c + 2); }
        LDS_BARRIER();
        {
            const int dvt = wave & 3;
            bf16x8 va[2], sa[4];
#pragma unroll
            for (int ks = 0; ks < 2; ++ks) va[ks] = *(const LAS bf16x8*)(lc + HB_VT + (dvt * 16 + fr) * H_TS + (ks * 32 + fq * 8) * 2);
#pragma unroll
            for (int kk = 0; kk < 4; ++kk) sa[kk] = *(const LAS bf16x8*)(lds + H_ST + (dvt * 16 + fr) * H_QS + (kk * 32 + fq * 8) * 2);
#pragma unroll
            for (int u = 0; u < 2; ++u) {
                const int tt = (wave >> 2) * 2 + u;
                f32x4 o4 = (f32x4){0.f, 0.f, 0.f, 0.f};
#pragma unroll
                for (int ks = 0; ks < 2; ++ks) { const bf16x8 pbf = *(const LAS bf16x8*)(lds + H_PM + (tt * 16 + fr) * H_TS + (ks * 32 + fq * 8) * 2); o4 = __builtin_amdgcn_mfma_f32_16x16x32_bf16(va[ks], pbf, o4, 0, 0, 0); }
#pragma unroll
                for (int kk = 0; kk < 4; ++kk) { const bf16x8 qb = *(const LAS bf16x8*)(lc + HB_QI + (tt * 16 + fr) * H_QS + (kk * 32 + fq * 8) * 2); o4 = __builtin_amdgcn_mfma_f32_16x16x32_bf16(sa[kk], qb, o4, 0, 0, 0); }
                *(f32x4*)(O + HG_TOK(c, tt * 16 + fr) * RGW + h * 128 + dvh * 64 + dvt * 16 + fq * 4) = o4;
            }
        }
        {
            bf16x8 ka[2];
#pragma unroll
            for (int ks = 0; ks < 2; ++ks) ka[ks] = *(const LAS bf16x8*)(lc + HB_KIT + (wave * 16 + fr) * H_TS + (ks * 32 + fq * 8) * 2);
#pragma unroll
            for (int dvt = 0; dvt < 4; ++dvt) {
#pragma unroll
                for (int ks = 0; ks < 2; ++ks) { const bf16x8 vb = *(const LAS bf16x8*)(lc + HB_VT + (dvt * 16 + fr) * H_TS + (ks * 32 + fq * 8) * 2); Sacc[dvt] = __builtin_amdgcn_mfma_f32_16x16x32_bf16(ka[ks], vb, Sacc[dvt], 0, 0, 0); }
                Sacc[dvt] = Sacc[dvt] * ec;
            }
        }
        if (c + 1 < SEQ / 64) HG_A2(cur ^ 1, ln);
        LDS_BARRIER();
    }
    __syncthreads();
#undef HG_A1
#undef HG_A2
#undef HG_LOAD
#undef HG_TOK
}

__device__ __forceinline__ void post_phase(const Params& p, int G, int layer) {
    const int tid = opaque_tid(), lane = tid & 63, wave = tid >> 6;
    const bf16_t* P = (const bf16_t*)(p.ws + WS_P); const float* OF = (const float*)(p.ws + WS_OF); const float* OB = (const float*)(p.ws + WS_OB);
    bf16_t* OA = (bf16_t*)(p.ws + WS_OA); const float* gain = p.rg_norm + layer * RGW;
    for (int pr = blockIdx.x * NWAVES + wave; pr < T * 8; pr += G * NWAVES) {
        const int tok = pr >> 3, h = pr & 7; const size_t off = (size_t)tok * RGW + h * 128 + 2 * lane;
        const f32x2 a = __builtin_nontemporal_load((const f32x2*)(OF + off)), bq = __builtin_nontemporal_load((const f32x2*)(OB + off));
        const float o0 = a[0] + bq[0], o1 = a[1] + bq[1];
        const float s = wave_sum(o0 * o0 + o1 * o1); const float r = rsqrtf(s * (1.0f / 128.0f) + EPS);
        const unsigned gw_ = __builtin_nontemporal_load((const unsigned*)(P + (size_t)tok * INC + PC_G + h * 128 + 2 * lane));
        const float g0 = bf_lo(gw_), g1 = bf_hi(gw_);
        const f32x2 gn = *(const f32x2*)(gain + h * 128 + 2 * lane);
        *(unsigned*)(OA + off) = pk2(o0 * r * gn[0] * (g0 * sigmoidf_(g0)), o1 * r * gn[1] * (g1 * sigmoidf_(g1)));
    }
}

constexpr int KST = 272;
constexpr int VST = 136;
__device__ __forceinline__ void attn_phase(const Params& p, LAS unsigned char* lds, int first, int stride, int layer) {
    const int tid = opaque_tid(), lane = tid & 63, wave = tid >> 6, fr = lane & 15, fq = lane >> 4;
    const bf16_t* P = (const bf16_t*)(p.ws + WS_P); bf16_t* OT = (bf16_t*)(p.ws + WS_OT);
    LAS unsigned char* Kt = lds;
    LAS unsigned char* Vt = lds + 64 * KST;
    for (int item = first; item < 4 * 16 * 8; item += stride) {
        const int h = item & 7, qb = (item >> 3) & 15, b = item >> 7, kvh = h >> 2;
        const float slope = exp2f(-(float)(h + 1)), sinkv = p.sink[layer * 8 + h];
        const int q0 = qb * 128, qw = q0 + wave * 16, qt = qw + fr;
        const size_t tokq = (size_t)b * SEQ + qt;
        bf16x8 Qf[4];
#pragma unroll
        for (int kk = 0; kk < 4; ++kk) Qf[kk] = __builtin_nontemporal_load((const bf16x8*)(P + tokq * INC + PC_AQ + h * 128 + kk * 32 + fq * 8));
        f32x4 Oa[8];
#pragma unroll
        for (int i = 0; i < 8; ++i) Oa[i] = (f32x4){0.f, 0.f, 0.f, 0.f};
        float mrun = sinkv, lrun = 1.0f;
        const int kb_lo = (q0 - 128 < 0) ? 2 : 0, kb_hi = (q0 + 256 > SEQ) ? 4 : 6;
        const int skey = tid >> 4, sd0 = (tid & 15) * 8;
        u32x4 kreg[2], vreg[2];
#define AT_LOAD(kb_) do { const int k0_ = q0 - 128 + (kb_) * 64; _Pragma("unroll") for (int i = 0; i < 2; ++i) { const size_t tk = (size_t)b * SEQ + k0_ + skey + i * 32; \
            kreg[i] = *(const u32x4*)(P + tk * INC + PC_AK + kvh * 128 + sd0); vreg[i] = *(const u32x4*)(P + tk * INC + PC_AV + kvh * 128 + sd0); } } while (0)
        AT_LOAD(kb_lo);
        for (int kb = kb_lo; kb < kb_hi; ++kb) {
            const int k0 = q0 - 128 + kb * 64;
            __syncthreads();
#pragma unroll
            for (int i = 0; i < 2; ++i) {
                const int key = skey + i * 32;
                *(LAS u32x4*)(Kt + key * KST + sd0 * 2) = kreg[i];
#pragma unroll
                for (int q = 0; q < 4; ++q) {
                    *(LAS bf16_t*)(Vt + (sd0 + 2 * q) * VST + key * 2) = (bf16_t)(vreg[i][q] & 0xffffu);
                    *(LAS bf16_t*)(Vt + (sd0 + 2 * q + 1) * VST + key * 2) = (bf16_t)(vreg[i][q] >> 16);
                }
            }
            __syncthreads();
            if (kb + 1 < kb_hi) AT_LOAD(kb + 1);
            if (k0 + 63 < qw - 128 || k0 > qw + 15 + 128) continue;
            f32x4 Sa[4];
#pragma unroll
            for (int t = 0; t < 4; ++t) {
                Sa[t] = (f32x4){0.f, 0.f, 0.f, 0.f};
#pragma unroll
                for (int kk = 0; kk < 4; ++kk) {
                    const bf16x8 kf = *(const LAS bf16x8*)(Kt + (t * 16 + fr) * KST + (kk * 32 + fq * 8) * 2);
                    Sa[t] = __builtin_amdgcn_mfma_f32_16x16x32_bf16(kf, Qf[kk], Sa[t], 0, 0, 0);
                }
            }
            float mloc = -INFINITY;
#pragma unroll
            for (int t = 0; t < 4; ++t)
#pragma unroll
                for (int j = 0; j < 4; ++j) {
                    const int kt = k0 + t * 16 + fq * 4 + j; const int rel = kt - qt; const int ar = rel < 0 ? -rel : rel;
                    float s = Sa[t][j] * 0.08838834764831845f - slope * (float)ar;
                    s = (ar <= 128) ? s : -INFINITY;
                    Sa[t][j] = s; mloc = fmaxf(mloc, s);
                }
            mloc = fmaxf(mloc, __shfl_xor(mloc, 16)); mloc = fmaxf(mloc, __shfl_xor(mloc, 32));
            const float mnew = fmaxf(mrun, mloc), alpha = fexp(mrun - mnew);
            float lsum = 0.f;
#pragma unroll
            for (int t = 0; t < 4; ++t)
#pragma unroll
                for (int j = 0; j < 4; ++j) { const float e = fexp(Sa[t][j] - mnew); Sa[t][j] = e; lsum += e; }
            lsum += __shfl_xor(lsum, 16); lsum += __shfl_xor(lsum, 32);
            lrun = lrun * alpha + lsum; mrun = mnew;
#pragma unroll
            for (int i = 0; i < 8; ++i) Oa[i] = Oa[i] * alpha;
            bf16x8 Pf[2];
#pragma unroll
            for (int s2 = 0; s2 < 2; ++s2) {
                u32x4 w; w.x = pk2(Sa[2 * s2][0], Sa[2 * s2][1]); w.y = pk2(Sa[2 * s2][2], Sa[2 * s2][3]); w.z = pk2(Sa[2 * s2 + 1][0], Sa[2 * s2 + 1][1]); w.w = pk2(Sa[2 * s2 + 1][2], Sa[2 * s2 + 1][3]);
                Pf[s2] = __builtin_bit_cast(bf16x8, w);
            }
#pragma unroll
            for (int dt = 0; dt < 8; ++dt)
#pragma unroll
                for (int s2 = 0; s2 < 2; ++s2) {
                    const LAS unsigned char* vp = Vt + (dt * 16 + fr) * VST + (s2 * 32 + fq * 4) * 2;
                    const u32x2 lo = *(const LAS u32x2*)vp, hi = *(const LAS u32x2*)(vp + 32);
                    u32x4 w; w.x = lo.x; w.y = lo.y; w.z = hi.x; w.w = hi.y;
                    Oa[dt] = __builtin_amdgcn_mfma_f32_16x16x32_bf16(__builtin_bit_cast(bf16x8, w), Pf[s2], Oa[dt], 0, 0, 0);
                }
        }
        const float inv = 1.0f / lrun;
#pragma unroll
        for (int dt = 0; dt < 8; ++dt) {
            u32x2 w; w.x = pk2(Oa[dt][0] * inv, Oa[dt][1] * inv); w.y = pk2(Oa[dt][2] * inv, Oa[dt][3] * inv);
            *(u32x2*)(OT + tokq * RGW + h * 128 + dt * 16 + fq * 4) = w;
        }
    }
}

__device__ __forceinline__ void final_phase(const Params& p, int G) {
    const int tid = opaque_tid(), lane = tid & 63, wave = tid >> 6;
    const bf16_t* XBp = (const bf16_t*)(p.ws + WS_XB); const ssq_t* ss = (const ssq_t*)(p.ws + WS_SS) + 6 * T;
    for (int row = blockIdx.x * NWAVES + wave; row < T; row += G * NWAVES) {
        const float r = row_rstd(ss, row);
        const u32x2* xr = (const u32x2*)(XBp + (size_t)row * D) + lane; const f32x4* gr = (const f32x4*)p.final_norm + lane; f32x4* o = (f32x4*)(p.out + (size_t)row * D) + lane;
#pragma unroll
        for (int j = 0; j < 8; ++j) { const u32x2 w = __builtin_nontemporal_load(xr + 64 * j); const f32x4 xv = (f32x4){bf_lo(w.x), bf_hi(w.x), bf_lo(w.y), bf_hi(w.y)}; __builtin_nontemporal_store(xv * r * gr[64 * j], o + 64 * j); }
    }
}

__global__ void __launch_bounds__(NTHREADS, 2) fwd_megakernel(Params p) {
    extern __shared__ __attribute__((aligned(16))) unsigned char lds_raw[];
    LAS unsigned char* lds = (LAS unsigned char*)lds_raw;
    cg::grid_group grid = cg::this_grid();
    if (threadIdx.x < 4) ((LAS unsigned*)(lds + LDS_BAR_OFF))[threadIdx.x] = 0u;
    __syncthreads();
    XcdBarrier xbar = xcd_barrier_post((unsigned*)(p.ws + WS_BAR), (volatile LAS unsigned*)(lds + LDS_BAR_OFF));
    if (p.ws == nullptr) grid.sync();
#define GSYNC() xcd_barrier(xbar)
    const int G = gridDim.x, c = blockIdx.x;
    unsigned char* ws = p.ws;
    float* X = (float*)(ws + WS_X); bf16_t* XB = (bf16_t*)(ws + WS_XB); ssq_t* SS = (ssq_t*)(ws + WS_SS);
    bf16_t* ACT = (bf16_t*)(ws + WS_ACT); bf16_t* Pb = (bf16_t*)(ws + WS_P);
    bf16_t* OA = (bf16_t*)(ws + WS_OA); bf16_t* OT = (bf16_t*)(ws + WS_OT); bf16_t* MG = (bf16_t*)(ws + WS_MG);

#ifndef PHMASK
#define PHMASK 0xffff
#endif
#define PH(n) ((PHMASK >> (n)) & 1)
#if PH(0)
    p0_prologue(p, lds, G);
#endif
    GSYNC();
#pragma unroll 1
    for (int l = 0; l < 2; ++l) {
        const unsigned char* wl = ws + (size_t)l * SZ_LAYER;
        const ssq_t* ss_ffn1 = SS + (3 * l + 0) * T; ssq_t* ss_mix = SS + (3 * l + 1) * T; ssq_t* ss_ffn2 = SS + (3 * l + 2) * T; ssq_t* ss_next = SS + (3 * l + 3) * T;
#if PH(1)
        { pg8::Gemm g{XB, (const bf16_t*)(wl + OFF_WGU1), XB, (const bf16_t*)(wl + OFF_WGU1), T, 2 * FF, D}; pg8::StaticOrder S; S.init(T, 2 * FF, G, c);
          EpiGU E{ss_ffn1, ACT}; pg8::gemm_phase(lds, g, S, E); }
        if (l == 0) tail_convert(p, lds, (T / 256) * (2 * FF / 256), G, c, I_P0, I_A);
#endif
        GSYNC();
#if PH(2)
        { pg8::Gemm g{ACT, (const bf16_t*)(wl + OFF_WD1), ACT, (const bf16_t*)(wl + OFF_WD1), T, D, FF}; pg8::StaticOrder S; S.init(T, D, G, c);
          EpiRes E{l == 0 ? p.x : nullptr, XB, ss_mix, 0.5f}; pg8::gemm_phase(lds, g, S, E); }
#endif
        GSYNC();
#if PH(3)
        { pg8::Gemm g{XB, (const bf16_t*)(wl + OFF_WIN), XB, (const bf16_t*)(wl + OFF_WIN), T, INC, D}; pg8::StaticOrder S; S.init(T, INC, G, c);
          EpiP E{ss_mix, Pb}; pg8::gemm_phase(lds, g, S, E); }
        tail_convert(p, lds, (T / 256) * (INC / 256), G, c, l * I_LAYER + I_A, (l + 1) * I_LAYER);
#endif
        GSYNC();
#if PH(4)
        { const int hw = (G >= 256) ? 128 : 0;
          if (hw == 0 || c < hw) for (int ch = c; ch < 128; ch += (hw ? 128 : G)) hgrn_chain(p, lds, l, ch >> 1, ch & 1);
          if (c >= hw) { attn_phase(p, lds, c - hw, G - hw, l); __syncthreads(); if (l == 0) convert_items(p, lds, I_LAYER, I_CUT2, (c - hw) * NWAVES + (opaque_tid() >> 6), (G - hw) * NWAVES); } }
#endif
        GSYNC();
#if PH(6)
        post_phase(p, G, l);
#endif
        GSYNC();
#if PH(7)
        { pg8::Gemm g{OA, (const bf16_t*)(wl + OFF_WA), OT, (const bf16_t*)(wl + OFF_WB), T, D, RGW}; pg8::PairOrder S; S.init(T, D, G, c);
          EpiMerge E{Pb, MG}; pg8::gemm_phase(lds, g, S, E); }
#endif
        GSYNC();
#if PH(8)
        { pg8::Gemm g{MG, (const bf16_t*)(wl + OFF_WOUT), MG, (const bf16_t*)(wl + OFF_WOUT), T, D, D}; pg8::StaticOrder S; S.init(T, D, G, c);
          EpiRes E{nullptr, XB, ss_ffn2, 1.0f}; pg8::gemm_phase(lds, g, S, E); }
#endif
        GSYNC();
#if PH(9)
        { pg8::Gemm g{XB, (const bf16_t*)(wl + OFF_WGU2), XB, (const bf16_t*)(wl + OFF_WGU2), T, 2 * FF, D}; pg8::StaticOrder S; S.init(T, 2 * FF, G, c);
          EpiGU E{ss_ffn2, ACT}; pg8::gemm_phase(lds, g, S, E); }
        if (l == 0) tail_convert(p, lds, (T / 256) * (2 * FF / 256), G, c, I_CUT2, I_LAYER + I_A);
#endif
        GSYNC();
#if PH(10)
        { pg8::Gemm g{ACT, (const bf16_t*)(wl + OFF_WD2), ACT, (const bf16_t*)(wl + OFF_WD2), T, D, FF}; pg8::StaticOrder S; S.init(T, D, G, c);
          EpiRes E{nullptr, XB, ss_next, 0.5f}; pg8::gemm_phase(lds, g, S, E); }
#endif
        GSYNC();
    }
#if PH(11)
    final_phase(p, G);
#endif
}

extern "C" void kernel_launch(void* const* d_in, const int* in_sizes, int n_in, void* d_out, int out_size, void* d_ws, size_t ws_size, hipStream_t stream) {
    static int grid_blocks = 0;
    if (grid_blocks == 0) {
        if (n_in != 19 || ws_size < WS_END) { fprintf(stderr, "kernel_launch: unexpected n_in %d / ws_size %zu (need %zu)\n", n_in, ws_size, (size_t)WS_END); grid_blocks = -1; return; }
        int dev = 0, cus = 0, per_cu = 0;
        hipGetDevice(&dev);
        hipDeviceGetAttribute(&cus, hipDeviceAttributeMultiprocessorCount, dev);
        hipFuncSetAttribute((const void*)fwd_megakernel, hipFuncAttributeMaxDynamicSharedMemorySize, LDS_BYTES);
        hipOccupancyMaxActiveBlocksPerMultiprocessor(&per_cu, (const void*)fwd_megakernel, NTHREADS, LDS_BYTES);
        if (per_cu < 1) { fprintf(stderr, "kernel_launch: occupancy query says %d blocks/CU\n", per_cu); per_cu = 1; }
        grid_blocks = cus * 1;
    }
    if (grid_blocks < 0) return;
    Params p{};
    p.x = (const float*)d_in[0]; p.ffn1_norm = (const float*)d_in[1]; p.ffn1_wg = (const float*)d_in[2]; p.ffn1_wu = (const float*)d_in[3]; p.ffn1_wd = (const float*)d_in[4];
    p.mix_norm = (const float*)d_in[5]; p.w_in = (const float*)d_in[6]; p.lbf = (const float*)d_in[7]; p.lbb = (const float*)d_in[8]; p.rg_norm = (const float*)d_in[9];
    p.sink = (const float*)d_in[10]; p.wa = (const float*)d_in[11]; p.wb = (const float*)d_in[12]; p.wout = (const float*)d_in[13];
    p.ffn2_norm = (const float*)d_in[14]; p.ffn2_wg = (const float*)d_in[15]; p.ffn2_wu = (const float*)d_in[16]; p.ffn2_wd = (const float*)d_in[17]; p.final_norm = (const float*)d_in[18];
    p.out = (float*)d_out; p.ws = (unsigned char*)d_ws;
    if (hipMemsetAsync((char*)d_ws + WS_BAR, 0, 16384, stream) != hipSuccess) { fprintf(stderr, "kernel_launch: memset failed\n"); return; }
    void* args[] = {&p};
    hipError_t e = hipLaunchCooperativeKernel((const void*)fwd_megakernel, dim3(grid_blocks), dim3(NTHREADS), args, LDS_BYTES, stream);
    if (e != hipSuccess) fprintf(stderr, "cooperative launch failed: %s (grid %d)\n", hipGetErrorString(e), grid_blocks);
}
```
